# Optimizing an MI355X kernel written in HIP

```python
import jax, jax.numpy as jnp
from jax import lax
import numpy as np

D_MODEL = 2048
BATCH = 2
SEQ = 4096
DEPTH = 1
DEC_BATCH = 32
DEC_SEQ = 1
PAST_LEN = 16384
PAGE_SIZE = 128

ATT_HEADS = 8
ATT_KV_HEADS = 2
ATT_HEAD_DIM = 128
ATT_WIDTH = ATT_HEADS * ATT_HEAD_DIM
ATT_KV_WIDTH = ATT_KV_HEADS * ATT_HEAD_DIM
ATT_SCALE = ATT_HEAD_DIM ** -0.5
IDX_HEADS = 16
IDX_DIM = 64
IDX_SCALE = (IDX_HEADS * IDX_DIM) ** -0.5
TOPK_MAX = 256
Q_BLOCK = 128
ML_HEADS = 4
ML_QK_DIM = 128
ML_V_DIM = 256
ML_WIDTH = ML_HEADS * ML_V_DIM
ML_CHUNK = 64
MIX_WIDTH = ATT_WIDTH + ML_WIDTH
RMS_EPS = 1e-6
IN_SIZES = (ATT_WIDTH, ATT_KV_WIDTH, ATT_KV_WIDTH, IDX_HEADS * IDX_DIM, IDX_DIM, IDX_HEADS, ATT_WIDTH,
            ML_HEADS * ML_QK_DIM, ML_HEADS * ML_QK_DIM, ML_WIDTH, ML_HEADS, ML_HEADS, ML_WIDTH, ML_WIDTH)
IN_WIDTH = sum(IN_SIZES)

kernel_name = "hymba_dsa_mlstm_decoder_step"


def rmsnorm(x, w):
    xf = x.astype(jnp.float32)
    y = xf * lax.rsqrt(jnp.mean(xf * xf, axis=-1, keepdims=True) + RMS_EPS) * w.astype(jnp.float32)
    return y.astype(x.dtype)


def project(h, w_in, b_i, b_f):
    B, T, _ = h.shape
    split_points = [int(s) for s in np.cumsum(IN_SIZES)[:-1]]
    (aq, ak, av, iq, ik, iw, az, mq, mk, mv, mi, mf, mo, mz) = jnp.split(h @ w_in, split_points, axis=-1)
    f32 = jnp.float32
    return dict(
        q=aq.reshape(B, T, ATT_HEADS, ATT_HEAD_DIM),
        k=ak.reshape(B, T, ATT_KV_HEADS, ATT_HEAD_DIM),
        v=av.reshape(B, T, ATT_KV_HEADS, ATT_HEAD_DIM),
        qi=iq.reshape(B, T, IDX_HEADS, IDX_DIM),
        ki=ik,
        wi=iw,
        az=az,
        mq=mq.reshape(B, T, ML_HEADS, ML_QK_DIM),
        mk=mk.reshape(B, T, ML_HEADS, ML_QK_DIM) * (ML_QK_DIM ** -0.5),
        mv=mv.reshape(B, T, ML_HEADS, ML_V_DIM),
        ig=mi.astype(f32) + b_i.astype(f32),
        lf=jax.nn.log_sigmoid(mf.astype(f32) + b_f.astype(f32)),
        mo=mo, mz=mz)


def indexer_scores(qi, ki, wi):
    s = jax.nn.relu(jnp.einsum('bqhd,bld->bqlh', qi.astype(jnp.float32), ki.astype(jnp.float32)))
    return jnp.einsum('bqlh,bqh->bql', s, wi.astype(jnp.float32)) * IDX_SCALE


def sparse_attend(q, kg, vg, valid):
    B, Q = q.shape[:2]
    G = ATT_HEADS // ATT_KV_HEADS
    qg = q.reshape(B, Q, ATT_KV_HEADS, G, ATT_HEAD_DIM).astype(jnp.float32)
    logits = jnp.einsum('bqhgd,bqjhd->bqhgj', qg, kg.astype(jnp.float32)) * ATT_SCALE
    logits = jnp.where(valid[:, :, None, None, :], logits, -jnp.inf)
    p = jax.nn.softmax(logits, axis=-1)
    o = jnp.einsum('bqhgj,bqjhd->bqhgd', p, vg.astype(jnp.float32))
    return o.reshape(B, Q, ATT_WIDTH)


def gather_rows(a, idx):
    return jax.vmap(lambda aa, ii: aa[ii])(a, idx)


def dsa_prompt(q, k, v, qi, ki, wi):
    B, S = q.shape[:2]
    topk = min(TOPK_MAX, S // 4)
    nb = S // Q_BLOCK
    key_pos = jnp.arange(S)

    def block(args):
        i, qb, qib, wib = args
        pos = i * Q_BLOCK + jnp.arange(Q_BLOCK)
        scores = indexer_scores(qib, ki, wib)
        scores = jnp.where((key_pos[None, :] <= pos[:, None])[None], scores, -jnp.inf)
        _, idx = lax.top_k(scores, topk)
        valid = idx <= pos[None, :, None]
        return sparse_attend(qb, gather_rows(k, idx), gather_rows(v, idx), valid)

    qb = q.reshape(B, nb, Q_BLOCK, ATT_HEADS, ATT_HEAD_DIM).swapaxes(0, 1)
    qib = qi.reshape(B, nb, Q_BLOCK, IDX_HEADS, IDX_DIM).swapaxes(0, 1)
    wib = wi.reshape(B, nb, Q_BLOCK, IDX_HEADS).swapaxes(0, 1)
    out = lax.map(block, (jnp.arange(nb), qb, qib, wib))
    return out.swapaxes(0, 1).reshape(B, S, ATT_WIDTH)


def dsa_sample(q, k_new, v_new, qi, ki_new, wi, cache_k, cache_v, cache_ik, page_table):
    Bd, T = q.shape[:2]
    past = page_table.shape[1] * PAGE_SIZE
    L = past + T
    topk = min(TOPK_MAX, L // 4)
    ki_past = cache_ik[page_table].reshape(Bd, past, IDX_DIM)
    ki_all = jnp.concatenate([ki_past, ki_new.astype(ki_past.dtype)], axis=1)
    scores = indexer_scores(qi, ki_all, wi)
    pos = past + jnp.arange(T)
    scores = jnp.where((jnp.arange(L)[None, :] <= pos[:, None])[None], scores, -jnp.inf)
    _, idx = lax.top_k(scores, topk)
    valid = idx <= pos[None, :, None]
    in_past = idx < past
    ip = jnp.minimum(idx, past - 1)
    phys = jax.vmap(lambda pt, ii: pt[ii])(page_table, ip // PAGE_SIZE)
    off = ip % PAGE_SIZE
    inew = jnp.clip(idx - past, 0, T - 1)
    kg = jnp.where(in_past[..., None, None], cache_k[phys, off], gather_rows(k_new.astype(cache_k.dtype), inew))
    vg = jnp.where(in_past[..., None, None], cache_v[phys, off], gather_rows(v_new.astype(cache_v.dtype), inew))
    return sparse_attend(q, kg, vg, valid)


def mlstm_chunk(carry, xs):
    C, n, m = carry
    q, k, v, ig, lf = xs
    L = q.shape[2]
    b = jnp.cumsum(lf, axis=-1)
    causal = jnp.tril(jnp.ones((L, L), dtype=bool))
    log_d = jnp.where(causal, b[..., :, None] - b[..., None, :] + ig[..., None, :], -jnp.inf)
    log_a = b + m[..., None]
    m_t = jnp.maximum(log_a, jnp.max(log_d, axis=-1))
    d = jnp.exp(log_d - m_t[..., None])
    a = jnp.exp(log_a - m_t)
    s = jnp.einsum('bhtd,bhsd->bhts', q, k) * d
    num = a[..., None] * jnp.einsum('bhvd,bhtd->bhtv', C, q) + jnp.einsum('bhts,bhsv->bhtv', s, v)
    den = a * jnp.einsum('bhd,bhtd->bht', n, q) + jnp.sum(s, axis=-1)
    h = num / jnp.maximum(jnp.abs(den), jnp.exp(-m_t))[..., None]
    m_new = m_t[..., -1]
    w = jnp.exp(b[..., -1:] - b + ig - m_new[..., None])
    a_end = a[..., -1]
    C_new = a_end[..., None, None] * C + jnp.einsum('bhs,bhsv,bhsd->bhvd', w, v, k)
    n_new = a_end[..., None] * n + jnp.einsum('bhs,bhsd->bhd', w, k)
    return (C_new, n_new, m_new), h


def mlstm_run(q, k, v, ig, lf, C0, n0, m0, chunk):
    B, T, H, _ = q.shape
    nc = T // chunk
    f32 = jnp.float32
    seq4 = lambda a: a.astype(f32).reshape(B, nc, chunk, H, a.shape[-1]).transpose(1, 0, 3, 2, 4)
    seq3 = lambda a: a.astype(f32).reshape(B, nc, chunk, H).transpose(1, 0, 3, 2)
    (C, n, m), h = lax.scan(mlstm_chunk, (C0.astype(f32), n0.astype(f32), m0.astype(f32)),
                            (seq4(q), seq4(k), seq4(v), seq3(ig), seq3(lf)))
    h = h.transpose(1, 0, 3, 2, 4).reshape(B, T, H, ML_V_DIM)
    return h, C, n, m


def merge(x, att_o, p, h_ml, ml_norm_w, w_out):
    B, T, _ = x.shape
    a = att_o.astype(x.dtype) * jax.nn.silu(p['az'])
    hn = h_ml * lax.rsqrt(jnp.mean(h_ml * h_ml, axis=-1, keepdims=True) + RMS_EPS)
    hn = hn * ml_norm_w.astype(jnp.float32).reshape(ML_HEADS, ML_V_DIM)
    mo = hn.reshape(B, T, ML_WIDTH).astype(x.dtype) * jax.nn.sigmoid(p['mo']) * jax.nn.silu(p['mz'])
    return x + jnp.concatenate([a, mo], axis=-1) @ w_out


def setup_inputs(seed: int = 0) -> dict:
    key = jax.random.key(seed)
    ks = jax.random.split(key, 20)
    n_pages = PAST_LEN // PAGE_SIZE
    used = DEC_BATCH * n_pages
    n_pool = used + max(1, used // 4)
    f32 = jnp.float32
    page_table = jax.random.permutation(ks[0], n_pool)[:used].reshape(DEC_BATCH, n_pages).astype(jnp.int32)
    return {
        'x_prompt': jax.random.normal(ks[1], (BATCH, SEQ, D_MODEL), f32),
        'x_sample': jax.random.normal(ks[2], (DEC_BATCH, DEC_SEQ, D_MODEL), f32),
        'cache_k': jax.random.normal(ks[3], (DEPTH, n_pool, PAGE_SIZE, ATT_KV_HEADS, ATT_HEAD_DIM), f32),
        'cache_v': jax.random.normal(ks[4], (DEPTH, n_pool, PAGE_SIZE, ATT_KV_HEADS, ATT_HEAD_DIM), f32),
        'cache_idx_k': jax.random.normal(ks[5], (DEPTH, n_pool, PAGE_SIZE, IDX_DIM), f32),
        'state_C': 0.1 * jax.random.normal(ks[6], (DEPTH, DEC_BATCH, ML_HEADS, ML_V_DIM, ML_QK_DIM), f32),
        'state_n': 0.5 * jax.random.normal(ks[7], (DEPTH, DEC_BATCH, ML_HEADS, ML_QK_DIM), f32),
        'state_m': jax.random.normal(ks[8], (DEPTH, DEC_BATCH, ML_HEADS), f32),
        'page_table': page_table,
        'norm_w': 1.0 + 0.01 * jax.random.normal(ks[9], (DEPTH, D_MODEL), f32),
        'w_in': jax.random.normal(ks[10], (DEPTH, D_MODEL, IN_WIDTH), f32) * D_MODEL ** -0.5,
        'b_igate': 0.1 * jax.random.normal(ks[11], (DEPTH, ML_HEADS), f32),
        'b_fgate': 3.0 + 0.1 * jax.random.normal(ks[12], (DEPTH, ML_HEADS), f32),
        'ml_norm_w': 1.0 + 0.01 * jax.random.normal(ks[13], (DEPTH, ML_WIDTH), f32),
        'w_out': jax.random.normal(ks[14], (DEPTH, MIX_WIDTH, D_MODEL), f32) * MIX_WIDTH ** -0.5,
        'final_norm_w': 1.0 + 0.01 * jax.random.normal(ks[15], (D_MODEL,), f32),
    }


def reference(x_prompt, x_sample, cache_k, cache_v, cache_idx_k, state_C, state_n, state_m, page_table,
              norm_w, w_in, b_igate, b_fgate, ml_norm_w, w_out, final_norm_w):
    xp, xs = x_prompt, x_sample
    Bp = xp.shape[0]
    kp_l, vp_l, ikp_l, Cp_l, np_l, mp_l = [], [], [], [], [], []
    ks_l, vs_l, iks_l, Cs_l, ns_l, ms_l = [], [], [], [], [], []
    for l in range(DEPTH):
        p = project(rmsnorm(xp, norm_w[l]), w_in[l], b_igate[l], b_fgate[l])
        att = dsa_prompt(p['q'], p['k'], p['v'], p['qi'], p['ki'], p['wi'])
        zC = jnp.zeros((Bp, ML_HEADS, ML_V_DIM, ML_QK_DIM), jnp.float32)
        zn = jnp.zeros((Bp, ML_HEADS, ML_QK_DIM), jnp.float32)
        zm = jnp.zeros((Bp, ML_HEADS), jnp.float32)
        h_ml, C1, n1, m1 = mlstm_run(p['mq'], p['mk'], p['mv'], p['ig'], p['lf'], zC, zn, zm, ML_CHUNK)
        xp = merge(xp, att, p, h_ml, ml_norm_w[l], w_out[l])
        kp_l.append(p['k']); vp_l.append(p['v']); ikp_l.append(p['ki'])
        Cp_l.append(C1); np_l.append(n1); mp_l.append(m1)
        s = project(rmsnorm(xs, norm_w[l]), w_in[l], b_igate[l], b_fgate[l])
        att_s = dsa_sample(s['q'], s['k'], s['v'], s['qi'], s['ki'], s['wi'],
                           cache_k[l], cache_v[l], cache_idx_k[l], page_table)
        h_s, C2, n2, m2 = mlstm_run(s['mq'], s['mk'], s['mv'], s['ig'], s['lf'],
                                    state_C[l], state_n[l], state_m[l], xs.shape[1])
        xs = merge(xs, att_s, s, h_s, ml_norm_w[l], w_out[l])
        ks_l.append(s['k']); vs_l.append(s['v']); iks_l.append(s['ki'])
        Cs_l.append(C2); ns_l.append(n2); ms_l.append(m2)
    y_prompt = rmsnorm(xp, final_norm_w)
    y_sample = rmsnorm(xs, final_norm_w)
    return (y_prompt, y_sample,
            jnp.stack(kp_l), jnp.stack(vp_l), jnp.stack(ikp_l), jnp.stack(Cp_l), jnp.stack(np_l), jnp.stack(mp_l),
            jnp.stack(ks_l), jnp.stack(vs_l), jnp.stack(iks_l), jnp.stack(Cs_l), jnp.stack(ns_l), jnp.stack(ms_l))
```

```cpp
#include <hip/hip_runtime.h>
#include <cstdio>
#include <cstdint>
namespace pg8 {
#define PG8_LAS __attribute__((address_space(3)))
typedef unsigned short bf16_t;
typedef short bf16x8 __attribute__((ext_vector_type(8)));
typedef float f32x4 __attribute__((ext_vector_type(4)));
typedef unsigned u32x4 __attribute__((ext_vector_type(4)));
constexpr int BM = 256, BK = 64, HALF = 128, HTB = HALF * BK * 2  , STAGE_BYTES = 8 * HTB, NXCD = 8, WGM = 8;

__host__ __device__ __forceinline__ int lds_byte(int r, int c) { const int st = (r >> 4) * 2 + (c >> 5), rr = r & 15, cc = c & 31, ob = rr * 64 + cc * 2; return st * 1024 + (ob ^ (((ob >> 9) & 1) << 5)); }
__host__ __device__ __forceinline__ void stage_rc(int b, int& R, int& C) { const int st = b / 1024, sb = b % 1024, swz = sb ^ (((sb >> 9) & 1) << 5); R = (st >> 1) * 16 + swz / 64; C = (st & 1) * 32 + (swz % 64) / 2; }
__host__ __device__ __forceinline__ int perm32(int rho) { const int n = rho >> 4, i = rho & 15; return 8 * (i >> 2) + 4 * n + (i & 3); }

struct Unit { int pm, pn; };
struct Gemm { const bf16_t* A; const bf16_t* Bt; int M, N, K; };

struct StaticOrder {
    int nM, nN, nwg, G, c;
    __host__ __device__ void init(int M, int N, int G_, int c_) { nM = M / BM; nN = N / BM; nwg = nM * nN; G = G_; c = c_; }
    __host__ __device__ bool next(int i, Unit& u) const {
        const long L = (long)i * G + c; if (L >= nwg) return false;
        int wgid = (int)L; { const int q = nwg / NXCD, r = nwg % NXCD, xcd = wgid % NXCD, off = wgid / NXCD; wgid = (xcd < r ? xcd * (q + 1) : r * (q + 1) + (xcd - r) * q) + off; }
        const int nig = WGM * nN, gid = wgid / nig, fm = gid * WGM, gsz = (nM - fm) < WGM ? (nM - fm) : WGM;
        u.pm = fm + ((wgid % nig) % gsz); u.pn = (wgid % nig) / gsz; return true;
    }
    __device__ __forceinline__ void a_ready(const Unit&) const {}
    __device__ __forceinline__ void done(const Unit&) const {}
};

__device__ __forceinline__ unsigned cvt_pk_bf16(float lo, float hi) { unsigned r; asm volatile("v_cvt_pk_bf16_f32 %0, %1, %2" : "=v"(r) : "v"(lo), "v"(hi)); return r; }
template <class Epi, class Sched, bool ALIGN_EPI = false, bool SP2 = false>
__device__ __forceinline__ void gemm_phase(PG8_LAS unsigned char* lds, const Gemm g, const Sched& S, const Epi& E) {
    const int tid = threadIdx.x, wid = __builtin_amdgcn_readfirstlane(tid >> 6), lane = tid & 63, wr = wid >> 2, wc = wid & 3, fr = lane & 15, fq = lane >> 4;
    const int K = g.K, nt = K / BK;
    unsigned voffA[2], voffB[2];
#pragma unroll
    for (int i = 0; i < 2; ++i) { int R, C; stage_rc(tid * 16 + i * 8192, R, C); const int Rb = Epi::PERM ? ((R & ~31) + perm32(R & 31)) : R;
        voffA[i] = (unsigned)(R * K + C) * 2u; voffB[i] = (unsigned)(Rb * K + C) * 2u; }
    const size_t kstep = (size_t)(BK * 2);
    const size_t hstep = (size_t)HALF * K * 2;
    const size_t tstep = 2 * hstep;
    const unsigned ldsw = (unsigned)wid * 1024u;
    const int aoff = lds_byte(wr * 64 + fr, fq * 8), boff = lds_byte(wc * 32 + fr, fq * 8);
#define PG8_SA(b, h) (((b) * 2 + (h)) * HTB)
#define PG8_SB(b, h) ((4 + (b) * 2 + (h)) * HTB)
#define PG8_STAGE(bufoff, gbase, voff) do { _Pragma("unroll") for (int _i = 0; _i < 2; ++_i) \
        __builtin_amdgcn_global_load_lds((const unsigned*)((const char*)(gbase) + (voff)[_i]), (PG8_LAS unsigned*)(lds + (bufoff) + ldsw + _i * 8192), 16, 0, 0); } while (0)
#define PG8_LDA(dst, b, h) do { _Pragma("unroll") for (int m = 0; m < 4; ++m) _Pragma("unroll") for (int k = 0; k < 2; ++k) dst[m][k] = *(const PG8_LAS bf16x8*)(lds + PG8_SA(b, h) + aoff + m * 2048 + k * 1024); } while (0)
#define PG8_LDB(dst, b, h) do { _Pragma("unroll") for (int n = 0; n < 2; ++n) _Pragma("unroll") for (int k = 0; k < 2; ++k) dst[n][k] = *(const PG8_LAS bf16x8*)(lds + PG8_SB(b, h) + boff + n * 2048 + k * 1024); } while (0)
#define PG8_MMA(ai, bj, At, Bt) do { __builtin_amdgcn_s_setprio(1); _Pragma("unroll") for (int m = 0; m < 4; ++m) _Pragma("unroll") for (int n = 0; n < 2; ++n) _Pragma("unroll") for (int k = 0; k < 2; ++k) \
        acc[ai][bj][m][n] = __builtin_amdgcn_mfma_f32_16x16x32_bf16(Bt[n][k], At[m][k], acc[ai][bj][m][n], 0, 0, 0); __builtin_amdgcn_s_setprio(0); } while (0)
#define PG8_WAIT_V(n) asm volatile("s_waitcnt vmcnt(" #n ")" ::: "memory")
#define PG8_WAIT_L(n) asm volatile("s_waitcnt lgkmcnt(" #n ")" ::: "memory")
#define PG8_BAR __builtin_amdgcn_s_barrier()
#define PG8_SCHED __builtin_amdgcn_sched_barrier(0)
    Unit cur, nxt; int ui = 0;
    if (!S.next(0, cur)) return;
    f32x4 acc[2][2][4][2];
#pragma unroll
    for (int a = 0; a < 2; ++a)
#pragma unroll
        for (int b = 0; b < 2; ++b)
#pragma unroll
            for (int m = 0; m < 4; ++m)
#pragma unroll
                for (int n = 0; n < 2; ++n) acc[a][b][m][n] = (f32x4){0.f, 0.f, 0.f, 0.f};
    bf16x8 At[4][2], B0[2][2], B1[2][2];
    const char* cA = (const char*)g.A + (size_t)cur.pm * tstep; const char* cB = (const char*)g.Bt + (size_t)cur.pn * tstep;
    S.a_ready(cur);
    if constexpr (SP2) {
        PG8_STAGE(PG8_SB(0, 0), cB, voffB); PG8_STAGE(PG8_SB(0, 1), cB + hstep, voffB); PG8_STAGE(PG8_SA(0, 0), cA, voffA); PG8_STAGE(PG8_SA(0, 1), cA + hstep, voffA);
        if (wr == 1) PG8_BAR;
        PG8_WAIT_V(2); PG8_BAR;
        PG8_STAGE(PG8_SB(1, 0), cB + kstep, voffB); PG8_STAGE(PG8_SA(1, 0), cA + kstep, voffA); PG8_STAGE(PG8_SB(1, 1), cB + hstep + kstep, voffB);
        PG8_WAIT_V(6); PG8_BAR;
    } else {
        PG8_STAGE(PG8_SB(0, 0), cB, voffB); PG8_STAGE(PG8_SA(0, 0), cA, voffA); PG8_STAGE(PG8_SB(0, 1), cB + hstep, voffB); PG8_STAGE(PG8_SA(0, 1), cA + hstep, voffA);
        if (wr == 1) PG8_BAR;
        PG8_WAIT_V(4); PG8_BAR;
        PG8_STAGE(PG8_SB(1, 0), cB + kstep, voffB); PG8_STAGE(PG8_SA(1, 0), cA + kstep, voffA); PG8_STAGE(PG8_SB(1, 1), cB + hstep + kstep, voffB);
        PG8_WAIT_V(6); PG8_BAR;
    }
    for (;;) {
        const bool has_next = S.next(ui + 1, nxt);
        const char* nA = has_next ? (const char*)g.A + (size_t)nxt.pm * tstep : cA; const char* nB = has_next ? (const char*)g.Bt + (size_t)nxt.pn * tstep : cB;
        for (int t = 0; t < nt; t += 2) {
            const bool last = (t == nt - 2);
            const char* a1 = cA + (size_t)(t + 1) * kstep;
            const char* a2 = last ? nA : cA + (size_t)(t + 2) * kstep; const char* b2 = last ? nB : cB + (size_t)(t + 2) * kstep;
            const char* a3 = a2 + kstep; const char* b3 = b2 + kstep;
            if (last && has_next) S.a_ready(nxt);
            if constexpr (SP2) {
            PG8_LDB(B0, 0, 0); PG8_LDB(B1, 0, 1); PG8_SCHED; PG8_LDA(At, 0, 0); PG8_STAGE(PG8_SA(1, 1), a1 + hstep, voffA);
            PG8_WAIT_V(8); PG8_WAIT_L(0); PG8_BAR; PG8_MMA(0, 0, At, B0); PG8_MMA(0, 1, At, B1); PG8_BAR; PG8_SCHED;
            PG8_LDA(At, 0, 1); PG8_STAGE(PG8_SB(0, 0), b2, voffB); PG8_STAGE(PG8_SB(0, 1), b2 + hstep, voffB); PG8_STAGE(PG8_SA(0, 0), a2, voffA);
            PG8_WAIT_V(8); PG8_WAIT_L(0); PG8_BAR; PG8_MMA(1, 0, At, B0); PG8_MMA(1, 1, At, B1); PG8_BAR; PG8_SCHED;
            PG8_LDB(B0, 1, 0); PG8_LDB(B1, 1, 1); PG8_SCHED; PG8_LDA(At, 1, 0); PG8_STAGE(PG8_SA(0, 1), a2 + hstep, voffA);
            PG8_WAIT_V(8); PG8_WAIT_L(0); PG8_BAR; PG8_MMA(0, 0, At, B0); PG8_MMA(0, 1, At, B1); PG8_BAR; PG8_SCHED;
            PG8_LDA(At, 1, 1); PG8_STAGE(PG8_SB(1, 0), b3, voffB); PG8_STAGE(PG8_SB(1, 1), b3 + hstep, voffB); PG8_STAGE(PG8_SA(1, 0), a3, voffA);
            PG8_WAIT_V(8); PG8_WAIT_L(0); PG8_BAR; PG8_MMA(1, 0, At, B0); PG8_MMA(1, 1, At, B1); PG8_BAR; PG8_SCHED;
            } else {
            PG8_LDB(B0, 0, 0); PG8_SCHED; PG8_LDA(At, 0, 0); PG8_STAGE(PG8_SA(1, 1), a1 + hstep, voffA);
            PG8_WAIT_L(8); PG8_BAR; PG8_WAIT_L(0); PG8_MMA(0, 0, At, B0); PG8_BAR; PG8_SCHED;
            PG8_LDB(B1, 0, 1); PG8_STAGE(PG8_SB(0, 0), b2, voffB);
            PG8_BAR; PG8_WAIT_L(0); PG8_MMA(0, 1, At, B1); PG8_BAR;
            PG8_LDA(At, 0, 1); PG8_STAGE(PG8_SA(0, 0), a2, voffA);
            PG8_BAR; PG8_WAIT_L(0); PG8_MMA(1, 0, At, B0); PG8_BAR; PG8_SCHED;
            PG8_STAGE(PG8_SB(0, 1), b2 + hstep, voffB);
            PG8_WAIT_V(6); PG8_BAR; PG8_MMA(1, 1, At, B1); PG8_BAR;
            PG8_LDB(B0, 1, 0); PG8_SCHED; PG8_LDA(At, 1, 0); PG8_STAGE(PG8_SA(0, 1), a2 + hstep, voffA);
            PG8_WAIT_L(8); PG8_BAR; PG8_WAIT_L(0); PG8_MMA(0, 0, At, B0); PG8_BAR; PG8_SCHED;
            PG8_LDB(B1, 1, 1); PG8_STAGE(PG8_SB(1, 0), b3, voffB);
            PG8_BAR; PG8_WAIT_L(0); PG8_MMA(0, 1, At, B1); PG8_BAR;
            PG8_LDA(At, 1, 1); PG8_STAGE(PG8_SA(1, 0), a3, voffA);
            PG8_BAR; PG8_WAIT_L(0); PG8_MMA(1, 0, At, B0); PG8_BAR; PG8_SCHED;
            PG8_STAGE(PG8_SB(1, 1), b3 + hstep, voffB);
            PG8_WAIT_V(6); PG8_BAR; PG8_MMA(1, 1, At, B1); PG8_BAR;
            }
        }
        if constexpr (ALIGN_EPI) { if (wr == 0) PG8_BAR; }
        if constexpr (!Epi::AFTER_DRAIN) { E(acc, cur, wr, wc, fr, fq); S.done(cur); }
        if (!has_next) break;
#pragma unroll
        for (int a = 0; a < 2; ++a)
#pragma unroll
            for (int b = 0; b < 2; ++b)
#pragma unroll
                for (int m = 0; m < 4; ++m)
#pragma unroll
                    for (int n = 0; n < 2; ++n) acc[a][b][m][n] = (f32x4){0.f, 0.f, 0.f, 0.f};
        cur = nxt; cA = nA; cB = nB; ++ui;
        if constexpr (ALIGN_EPI) { if (wr == 1) PG8_BAR; }
    }
    PG8_WAIT_V(0);
    if constexpr (!ALIGN_EPI) { if (wr == 0) PG8_BAR; }
    PG8_BAR;
    if constexpr (Epi::AFTER_DRAIN) { E.fused(acc, cur, wr, wc, fr, fq, lds, wid, lane); S.done(cur); }
#undef PG8_SA
#undef PG8_SB
#undef PG8_STAGE
#undef PG8_LDA
#undef PG8_LDB
#undef PG8_MMA
#undef PG8_WAIT_V
#undef PG8_WAIT_L
#undef PG8_BAR
#undef PG8_SCHED
}
}

constexpr int NWAVES = 8, NTHR = 512;
constexpr int DM = 2048, SEQ = 4096, NB = 2, MP = NB * SEQ  , MS = 32  , MROWS = MP + MS, MPAD = 8448  ;
constexpr int NIN = 7768, NPAD = 7936  ;
constexpr int C_Q = 0, C_K = 1024, C_V = 1280, C_IQ = 1536, C_AZ = 2560, C_MQ = 3584, C_MK = 4096, C_MV = 4608, C_MO = 5632, C_MZ = 6656, C_MISC = 7680;
constexpr int PN_K = 4, PN_V = 5, PN_MK0 = 16, PN_MK1 = 17, PN_MISC = 30;
constexpr int PAST = 16384, PAGE = 128, NPAGES = 128, LS = PAST + 1, SSP = 16640  ;
constexpr float RMS_EPS = 1e-6f;
constexpr int SCP = SEQ + 32, BMP = SEQ + 32, SCPH = SEQ + 64;
constexpr float ATT_C = 0.08838834764831845f * 1.4426950408889634f;
constexpr float MK_SCALE = 0.08838834764831845f;
constexpr size_t O_Y = 0, O_YS = 16777216, O_KP = 16842752, O_VP = 18939904, O_IKP = 21037056, O_CP = 21561344, O_NP = 21823488, O_MPR = 21824512,
                 O_KS = 21824520, O_VS = 21832712, O_IKS = 21840904, O_CS = 21842952, O_NS = 26037256, O_MSS = 26053640, O_END = 26053768;
constexpr size_t MiB = 1u << 20;
constexpr size_t WS_CTL = 0, CTL_ZERO_BYTES = 65536;
constexpr size_t WS_WINT = 2 * MiB;
constexpr size_t WS_WOUTT = 34 * MiB;
constexpr size_t WS_XN = 42 * MiB;
constexpr size_t WS_P = 76 * MiB;
constexpr size_t WS_WI = 204 * MiB;
constexpr size_t WS_IG = 205 * MiB;
constexpr size_t WS_LF = 206 * MiB;
constexpr size_t WS_KIB = 207 * MiB;
constexpr size_t WS_BMT = 210 * MiB;
constexpr size_t WS_MIX = 214 * MiB;
constexpr size_t WS_UN = 248 * MiB;
constexpr size_t WS_CHG = 249 * MiB;
constexpr size_t WS_NST = 250 * MiB;
constexpr size_t WS_MST = 251 * MiB;
constexpr size_t WS_SS = 252 * MiB;
constexpr size_t WS_SIDX = 255 * MiB;
constexpr size_t WS_SC = 256 * MiB;
constexpr size_t WS_UP = 384 * MiB;
constexpr size_t WS_CST = 448 * MiB;
constexpr size_t WS_XCH = 480 * MiB;
constexpr size_t WS_KVC = 482 * MiB;
constexpr size_t WS_SC2 = 492 * MiB;
constexpr size_t WS_BMT2 = 624 * MiB;
constexpr size_t WS_END = 630 * MiB;
constexpr int CW_BAR = 4096;
constexpr int CW_PCNT = 8192, CW_SCNT = 12288;
constexpr int RING_BYTES = 159744, MISC_OFF = RING_BYTES, LDS_BYTES = RING_BYTES + 1024;

#define GAS __attribute__((address_space(1)))
#define LAS __attribute__((address_space(3)))
typedef unsigned short bf16;
typedef unsigned v4u __attribute__((ext_vector_type(4)));
typedef unsigned v2u __attribute__((ext_vector_type(2)));
typedef _Float16 h16x2 __attribute__((ext_vector_type(2)));
typedef float f32x4 __attribute__((ext_vector_type(4)));
typedef float f32x2 __attribute__((ext_vector_type(2)));
typedef float f32x16 __attribute__((ext_vector_type(16)));
typedef short bf16x8 __attribute__((ext_vector_type(8)));
typedef short s16x4 __attribute__((ext_vector_type(4)));
#define LDS_WAIT() asm volatile("s_waitcnt lgkmcnt(0)" ::: "memory")
#define VM_WAIT() asm volatile("s_waitcnt vmcnt(0)" ::: "memory")
__device__ __forceinline__ unsigned f2bf(float f) { unsigned u = __builtin_bit_cast(unsigned, f); return (u + 0x7fffu + ((u >> 16) & 1u)) >> 16; }
__device__ __forceinline__ unsigned pk2(float lo, float hi) { return f2bf(lo) | (f2bf(hi) << 16); }
__device__ __forceinline__ float bflo(unsigned w) { return __builtin_bit_cast(float, w << 16); }
__device__ __forceinline__ float bfhi(unsigned w) { return __builtin_bit_cast(float, w & 0xffff0000u); }
__device__ __forceinline__ float bf1(bf16 b) { return __builtin_bit_cast(float, (unsigned)b << 16); }
__device__ __forceinline__ float wave_sum(float v) {
#pragma unroll
    for (int o = 1; o < 64; o <<= 1) v += __shfl_xor(v, o);
    return v;
}
__device__ __forceinline__ float wave_max(float v) {
#pragma unroll
    for (int o = 1; o < 64; o <<= 1) v = fmaxf(v, __shfl_xor(v, o));
    return v;
}
__device__ __forceinline__ float sigmoidf_(float x) { return __builtin_amdgcn_rcpf(1.f + __expf(-x)); }
__device__ __forceinline__ float siluf_(float x) { return x * __builtin_amdgcn_rcpf(1.f + __expf(-x)); }
typedef __bf16 bf16x2_t __attribute__((ext_vector_type(2)));
__device__ __forceinline__ unsigned cvt2(float a, float b) { f32x2 v = {a, b}; bf16x2_t r = __builtin_convertvector(v, bf16x2_t); return __builtin_bit_cast(unsigned, r); }
#define MFMA32(a, b, c) __builtin_amdgcn_mfma_f32_32x32x16_bf16((a), (b), (c), 0, 0, 0)
__device__ __forceinline__ f32x16 zero16() { f32x16 z; _Pragma("unroll") for (int i = 0; i < 16; ++i) z[i] = 0.f; return z; }
__device__ __forceinline__ s16x4 tr_read4(LAS unsigned char* base, int row0, int col0, int rp, int lane) {
    const int q = (lane & 15) >> 2, p = lane & 3;
    return __builtin_amdgcn_ds_read_tr16_b64_v4i16((LAS s16x4*)(base + (row0 + q) * rp + (col0 + 4 * p) * 2));
}
__device__ __forceinline__ bf16x8 cat8(s16x4 lo, s16x4 hi) { return __builtin_shufflevector(lo, hi, 0, 1, 2, 3, 4, 5, 6, 7); }


__device__ __forceinline__ int wave_sum_i(int x) {
    x += __builtin_amdgcn_update_dpp(0, x, 0xB1, 0xF, 0xF, true);
    x += __builtin_amdgcn_update_dpp(0, x, 0x4E, 0xF, 0xF, true);
    x += __builtin_amdgcn_update_dpp(0, x, 0x141, 0xF, 0xF, true);
    x += __builtin_amdgcn_update_dpp(0, x, 0x140, 0xF, 0xF, true);
    return __builtin_amdgcn_readlane(x, 0) + __builtin_amdgcn_readlane(x, 16) + __builtin_amdgcn_readlane(x, 32) + __builtin_amdgcn_readlane(x, 48);
}
__device__ __forceinline__ float row16_sum(float v) {
    v += __builtin_bit_cast(float, __builtin_amdgcn_update_dpp(0, __builtin_bit_cast(int, v), 0xB1, 0xF, 0xF, true));
    v += __builtin_bit_cast(float, __builtin_amdgcn_update_dpp(0, __builtin_bit_cast(int, v), 0x4E, 0xF, 0xF, true));
    v += __builtin_bit_cast(float, __builtin_amdgcn_update_dpp(0, __builtin_bit_cast(int, v), 0x141, 0xF, 0xF, true));
    v += __builtin_bit_cast(float, __builtin_amdgcn_update_dpp(0, __builtin_bit_cast(int, v), 0x140, 0xF, 0xF, true));
    return v;
}

__device__ __forceinline__ float xhalf_max(float x) { return fmaxf(x, __shfl_xor(x, 32)); }
__device__ __forceinline__ float xhalf_sum(float x) { return x + __shfl_xor(x, 32); }

__device__ __forceinline__ void st_wt16(void* p, v4u v) { asm volatile("global_store_dwordx4 %0, %1, off sc0 sc1\n\ts_nop 0" :: "v"(p), "v"(v) : "memory"); }
__device__ __forceinline__ void st_wt8(void* p, v2u v) { asm volatile("global_store_dwordx2 %0, %1, off sc0 sc1\n\ts_nop 0" :: "v"(p), "v"(v) : "memory"); }
__device__ __forceinline__ void st_wt4(void* p, unsigned v) { asm volatile("global_store_dword %0, %1, off sc0 sc1\n\ts_nop 0" :: "v"(p), "v"(v) : "memory"); }
#define XB_TMO      128
#define XB_XCNT(j)  (256  + 64 * (j))
#define XB_XSUB(j)  (1280 + 64 * (j))
#define XB_XGEN(j)  (2304 + 64 * (j))
#define XB_TOP      3328
#define XB_TOPGEN   3392
#define XCD_BAR_WORDS 3456
#define XB_SPIN_CAP (1u << 18)

__device__ __forceinline__ unsigned xb_ld(unsigned* p)              { return __hip_atomic_load(p, __ATOMIC_RELAXED, __HIP_MEMORY_SCOPE_AGENT); }
__device__ __forceinline__ unsigned xb_add(unsigned* p, unsigned v) { return __hip_atomic_fetch_add(p, v, __ATOMIC_RELAXED, __HIP_MEMORY_SCOPE_AGENT); }
__device__ __forceinline__ unsigned xb_xcc_id() { return (unsigned)__builtin_amdgcn_s_getreg((3 << 11) | 20) & 0xFu; }
#define XB_SPIN(cond, bar) do { unsigned _sp = 0; while (cond) { __builtin_amdgcn_s_sleep(1); \
    if ((++_sp & 255u) == 0u) { if (xb_ld(&(bar)[XB_TMO])) break; if (_sp > XB_SPIN_CAP) { atomicAdd(&(bar)[XB_TMO], 1u); break; } } } } while (0)

struct XcdBarrier {
    unsigned* bar; unsigned x;
    volatile LAS unsigned* st;
};

__device__ __forceinline__ XcdBarrier xcd_barrier_post(unsigned* bar, volatile LAS unsigned* st) {
    XcdBarrier b; b.bar = bar; b.x = xb_xcc_id(); b.st = st;
    if (threadIdx.x == 0) (void)xb_add(&bar[XB_XCNT(b.x)], 1u);
    return b;
}
__device__ __forceinline__ void xcd_barrier_complete(unsigned* bar, unsigned x, unsigned& nloc, unsigned& nx) {
    const unsigned G = gridDim.x * gridDim.y * gridDim.z;
    unsigned sum, cnt, mine, sp = 0u;
    for (;;) {
        sum = 0u; cnt = 0u; mine = 0u;
#pragma unroll
        for (unsigned j = 0; j < 16; ++j) { const unsigned c = xb_ld(&bar[XB_XCNT(j)]); sum += c; cnt += (c > 0u) ? 1u : 0u; mine = (j == x) ? c : mine; }
        if (sum == G) break;
        __builtin_amdgcn_s_sleep(1);
        if ((++sp & 255u) == 0u) { if (xb_ld(&bar[XB_TMO])) break; if (sp > XB_SPIN_CAP) { atomicAdd(&bar[XB_TMO], 1u); break; } }
    }
    nloc = mine > 0u ? mine : 1u; nx = cnt > 0u ? cnt : 1u;
}

__device__ __forceinline__ void xcd_barrier(const XcdBarrier& b) {
    asm volatile("s_waitcnt vmcnt(0)" ::: "memory");
    __syncthreads();
    if (threadIdx.x == 0) {
        unsigned* bar = b.bar;
        __builtin_amdgcn_s_waitcnt(0);
        unsigned nloc = b.st[0], nx = b.st[1];
        if (nloc == 0u) { xcd_barrier_complete(bar, b.x, nloc, nx); b.st[0] = nloc; b.st[1] = nx; }
        const unsigned old = xb_add(&bar[XB_XSUB(b.x)], 1u);
        const unsigned gen = old / nloc;
        if (old + 1u == (gen + 1u) * nloc) {
            __builtin_amdgcn_fence(__ATOMIC_RELEASE, "agent");
            asm volatile("s_waitcnt vmcnt(0)" ::: "memory");
            const unsigned og = xb_add(&bar[XB_TOP], 1u);
            const unsigned tg = og / nx;
            if (og + 1u == (tg + 1u) * nx) xb_add(&bar[XB_TOPGEN], 1u);
            else XB_SPIN(xb_ld(&bar[XB_TOPGEN]) == tg, bar);
            __builtin_amdgcn_fence(__ATOMIC_ACQUIRE, "agent");
            xb_add(&bar[XB_XGEN(b.x)], 1u);
            asm volatile("s_waitcnt vmcnt(0)" ::: "memory");
        } else {
            XB_SPIN(xb_ld(&bar[XB_XGEN(b.x)]) == gen, bar);
            __builtin_amdgcn_fence(__ATOMIC_ACQUIRE, "agent");
            asm volatile("s_waitcnt vmcnt(0)" ::: "memory");
        }
    }
    __syncthreads();
}
struct Frame {
    LAS unsigned char* lds;
    int tid, lane, wave;
    int vcu, G;
    const float *x_prompt, *x_sample, *cache_k, *cache_v, *cache_ik, *state_C, *state_n, *state_m;
    const int* page_table;
    const float *norm_w, *w_in, *b_i, *b_f, *ml_norm_w, *w_out, *final_norm_w;
    float* out;
    bf16 *WINT, *WOUTT, *XN, *P, *KIB, *MIX, *CST, *KVC;
    float *WI, *IG, *LF, *UN, *CHG, *NST, *MST, *SS, *SC, *UP;
    unsigned* BMT; int* SIDX;
    XcdBarrier* bar;
    float* XCH; unsigned* ctl; int two;
};
#ifndef DUP_SUB
#define DUP_SUB 0
#endif
#define REPEAT(id) for (int rep_ = 0, nrep_ = (DUP_SUB == (id)) ? F.two : 1; rep_ < nrep_; ++rep_)
#define REP_BAR() do { if (nrep_ > 1) xcd_barrier(*F.bar); } while (0)

__device__ __forceinline__ int win_origcol(int c) {
    if (c < 2560) return c;
    if (c < 5632) return c + 80;
    if (c < 7680) return c + 88;
    if (c < 7744) return 2560 + (c - 7680);
    if (c < 7760) return 2624 + (c - 7744);
    if (c < 7764) return 5712 + (c - 7760);
    if (c < 7768) return 5716 + (c - 7764);
    return -1;
}
template <bool REMAP>
__device__ __forceinline__ void p0_transpose_item(const float* W, int K, int Nsrc, int N, bf16* WT, LAS float* scr, int item, int lane) {
    const int nblk = N / 32, kb = item / nblk, nb = item % nblk, k0 = 64 * kb, n0 = 32 * nb;
    const int mycol = n0 + (lane & 31); const int oc = REMAP ? win_origcol(mycol) : mycol;
    float wv[32];
#pragma unroll
    for (int i = 0; i < 32; ++i) wv[i] = (oc >= 0) ? __builtin_nontemporal_load(W + (size_t)(k0 + 2 * i + (lane >> 5)) * Nsrc + oc) : 0.f;
#pragma unroll
    for (int i = 0; i < 32; ++i) scr[(2 * i + (lane >> 5)) * 33 + (lane & 31)] = wv[i];
    LDS_WAIT(); asm volatile("" ::: "memory");
    const int c = lane & 7;
#pragma unroll
    for (int j = 0; j < 4; ++j) { const int n = (lane >> 3) + 8 * j; const LAS float* s = scr + (8 * c) * 33 + n;
        v4u o; o.x = cvt2(s[0 * 33], s[1 * 33]); o.y = cvt2(s[2 * 33], s[3 * 33]); o.z = cvt2(s[4 * 33], s[5 * 33]); o.w = cvt2(s[6 * 33], s[7 * 33]);
        *(GAS v4u*)(WT + (size_t)(n0 + n) * K + k0 + 8 * c) = o; }
    LDS_WAIT(); asm volatile("" ::: "memory");
}
__device__ __forceinline__ void rms_row_to_bf16(const float* xrow, const float* w, bf16* orow, int lane) {
    const GAS f32x4* xr = (const GAS f32x4*)xrow + lane; const GAS f32x4* wr = (const GAS f32x4*)w + lane;
    f32x4 v[8]; float s = 0.f;
#pragma unroll
    for (int j = 0; j < 8; ++j) { v[j] = xr[64 * j]; s += (v[j].x * v[j].x + v[j].y * v[j].y) + (v[j].z * v[j].z + v[j].w * v[j].w); }
    const float rstd = 1.f / sqrtf(wave_sum(s) * (1.f / DM) + RMS_EPS);
    GAS v2u* o8 = (GAS v2u*)orow + lane;
#pragma unroll
    for (int j = 0; j < 8; ++j) { const f32x4 ww = wr[64 * j]; v2u o; o.x = cvt2(v[j].x * rstd * ww.x, v[j].y * rstd * ww.y); o.y = cvt2(v[j].z * rstd * ww.z, v[j].w * rstd * ww.w); o8[64 * j] = o; }
}
__device__ __forceinline__ void p0_prologue(Frame& F) {
    LAS float* scr = (LAS float*)(F.lds + F.wave * 16384);
    const int gw = F.vcu * NWAVES + F.wave, NGW = F.G * NWAVES;
    constexpr int I_IN = (DM / 64) * (NPAD / 32), I_OUT = (DM / 64) * (DM / 32);
    for (int it = gw; it < I_IN + I_OUT; it += NGW) {
        if (it < I_IN) p0_transpose_item<true>(F.w_in, DM, NIN, NPAD, F.WINT, scr, it, F.lane);
        else p0_transpose_item<false>(F.w_out, DM, DM, DM, F.WOUTT, scr, it - I_IN, F.lane);
    }
    auto rowsrc = [&](int m) -> const float* { return (m < MP) ? F.x_prompt + (size_t)m * DM : F.x_sample + (size_t)(m - MP) * DM; };
    f32x4 va[8], vb[8], wn[8];
    { const GAS f32x4* wr = (const GAS f32x4*)F.norm_w + F.lane;
#pragma unroll
      for (int j = 0; j < 8; ++j) wn[j] = wr[64 * j]; }
    int m = gw;
    if (m < MROWS) { const GAS f32x4* xr = (const GAS f32x4*)rowsrc(m) + F.lane;
#pragma unroll
        for (int j = 0; j < 8; ++j) va[j] = __builtin_nontemporal_load(xr + 64 * j); }
#pragma unroll 1
    for (; m < MROWS; m += NGW) {
        const int mn = m + NGW;
        if (mn < MROWS) { const GAS f32x4* xr = (const GAS f32x4*)rowsrc(mn) + F.lane;
#pragma unroll
            for (int j = 0; j < 8; ++j) vb[j] = __builtin_nontemporal_load(xr + 64 * j); }
        float s = 0.f;
#pragma unroll
        for (int j = 0; j < 8; ++j) s += (va[j].x * va[j].x + va[j].y * va[j].y) + (va[j].z * va[j].z + va[j].w * va[j].w);
        const float rstd = 1.f / sqrtf(wave_sum(s) * (1.f / DM) + RMS_EPS);
        GAS v2u* o8 = (GAS v2u*)(F.XN + (size_t)m * DM) + F.lane;
#pragma unroll
        for (int j = 0; j < 8; ++j) { const f32x4 ww = wn[j]; v2u o; o.x = cvt2(va[j].x * rstd * ww.x, va[j].y * rstd * ww.y); o.y = cvt2(va[j].z * rstd * ww.z, va[j].w * rstd * ww.w); o8[64 * j] = o; }
#pragma unroll
        for (int j = 0; j < 8; ++j) va[j] = vb[j];
    }
    for (int mz = MROWS + gw; mz < MPAD; mz += NGW) { GAS v4u* o = (GAS v4u*)(F.XN + (size_t)mz * DM) + F.lane;
#pragma unroll
        for (int j = 0; j < 4; ++j) o[64 * j] = (v4u){0u, 0u, 0u, 0u}; }
}

__device__ __forceinline__ float log_sigmoidf_(float x) { return fminf(x, 0.f) - log1pf(__expf(-fabsf(x))); }
struct EpiIn {
    static constexpr bool PERM = true, AFTER_DRAIN = false;
    bf16* P; float* out; float* WI; float* IG; float* LF; bf16* KIB; const float* b_i; const float* b_f; bf16* KVC;
    __device__ __forceinline__ void operator()(const pg8::f32x4 (&acc)[2][2][4][2], const pg8::Unit& u, int wr, int wc, int fr, int fq) const {
        const int row0 = u.pm * 256 + wr * 64 + fr, g8 = wc * 32 + 8 * fq, col0 = u.pn * 256 + g8;
        const float sc = (u.pn == PN_MK0 || u.pn == PN_MK1) ? MK_SCALE : 1.f;
#pragma unroll
        for (int ai = 0; ai < 2; ++ai)
#pragma unroll
            for (int m = 0; m < 4; ++m) {
                const int row = row0 + ai * 128 + m * 16;
                if (row < MROWS) {
                    bf16* rowp = P + (size_t)row * NPAD + col0;
#pragma unroll
                    for (int bj = 0; bj < 2; ++bj) { const f32x4 v0 = acc[ai][bj][m][0] * sc, v1 = acc[ai][bj][m][1] * sc;
                        v4u w; w.x = pg8::cvt_pk_bf16(v0[0], v0[1]); w.y = pg8::cvt_pk_bf16(v0[2], v0[3]); w.z = pg8::cvt_pk_bf16(v1[0], v1[1]); w.w = pg8::cvt_pk_bf16(v1[2], v1[3]);
                        *(v4u*)(rowp + bj * 128) = w; }
                    if (u.pn == PN_K || u.pn == PN_V) {
                        float* dst = (row < MP) ? out + (u.pn == PN_K ? O_KP : O_VP) + (size_t)row * 256 : out + (u.pn == PN_K ? O_KS : O_VS) + (size_t)(row - MP) * 256;
#pragma unroll
                        for (int bj = 0; bj < 2; ++bj) { *(f32x4*)(dst + g8 + bj * 128) = acc[ai][bj][m][0]; *(f32x4*)(dst + g8 + bj * 128 + 4) = acc[ai][bj][m][1]; }
                        if (row < MP) {
#pragma unroll
                            for (int bj = 0; bj < 2; ++bj) { const f32x4 v0 = acc[ai][bj][m][0], v1 = acc[ai][bj][m][1];
                                v4u w; w.x = pg8::cvt_pk_bf16(v0[0], v0[1]); w.y = pg8::cvt_pk_bf16(v0[2], v0[3]); w.z = pg8::cvt_pk_bf16(v1[0], v1[1]); w.w = pg8::cvt_pk_bf16(v1[2], v1[3]);
                                *(v4u*)(KVC + ((size_t)(((row >> 12) * 2 + bj) * SEQ + (row & 4095))) * 256 + (u.pn == PN_V ? 128 : 0) + g8) = w; }
                        }
                    }
                    if (u.pn == PN_MISC) {
                        const f32x4 v0 = acc[ai][0][m][0], v1 = acc[ai][0][m][1];
                        if (g8 < 64) {
                            float* dst = (row < MP) ? out + O_IKP + (size_t)row * 64 : out + O_IKS + (size_t)(row - MP) * 64;
                            *(f32x4*)(dst + g8) = v0; *(f32x4*)(dst + g8 + 4) = v1;
                            v4u w; w.x = pg8::cvt_pk_bf16(v0[0], v0[1]); w.y = pg8::cvt_pk_bf16(v0[2], v0[3]); w.z = pg8::cvt_pk_bf16(v1[0], v1[1]); w.w = pg8::cvt_pk_bf16(v1[2], v1[3]);
                            *(v4u*)(KIB + (size_t)row * 64 + g8) = w;
                        } else if (g8 < 80) {
                            *(f32x4*)(WI + (size_t)row * 16 + (g8 - 64)) = v0; *(f32x4*)(WI + (size_t)row * 16 + (g8 - 64) + 4) = v1;
                        } else if (g8 == 80) {
                            f32x4 ig, lf;
#pragma unroll
                            for (int j = 0; j < 4; ++j) { ig[j] = v0[j] + b_i[j]; lf[j] = log_sigmoidf_(v1[j] + b_f[j]); }
                            *(f32x4*)(IG + (size_t)row * 4) = ig; *(f32x4*)(LF + (size_t)row * 4) = lf;
                        }
                    }
                }
            }
    }
};
constexpr int P2_NS = 128, P2_WA = 3;
constexpr int IXPAD = 32;
constexpr int RPQ = 2192;
template <int MODE>
__device__ __forceinline__ void p2_indexer(Frame& F) {
    const int lane = F.lane, r = lane & 31, hh = lane >> 5;
    LAS float* wl = (LAS float*)(F.lds + 32 * RPQ);
    constexpr int TPB = 128 * 129 / 2, VPB = TPB + 128 * IXPAD, VTOT = 2 * VPB;
    const int ns = (F.G == 256) ? P2_NS : 0;
    auto cumw = [&](int i) -> long { return i < ns ? (long)i * P2_WA : (long)ns * P2_WA + (long)(i - ns) * 16; };
    const long totw = cumw(F.G);
    const int lo = (int)((long)VTOT * cumw(blockIdx.x) / totw), hi = (int)((long)VTOT * cumw(blockIdx.x + 1) / totw);
    int idx = lo;
    while (idx < hi) {
        const int b = idx / VPB, rr = idx % VPB;
        int qt = (int)((sqrtf((float)((2 * IXPAD + 1) * (2 * IXPAD + 1)) + 8.f * (float)rr) - (float)(2 * IXPAD + 1)) * 0.5f);
        while (qt * (qt + 1) / 2 + IXPAD * qt > rr) --qt;
        while ((qt + 1) * (qt + 2) / 2 + IXPAD * (qt + 1) <= rr) ++qt;
        const int off = rr - (qt * (qt + 1) / 2 + IXPAD * qt);
        const int rowend = idx - off + IXPAD + qt + 1;
        const int kt0 = off > IXPAD ? off - IXPAD : 0;
        const int nk = (rowend < hi ? rowend : hi) - (idx - off + IXPAD + kt0);
        idx = rowend;
        if (nk <= 0) continue;
        const int qrow0 = b * SEQ + 32 * qt;
        __syncthreads();
#pragma unroll
        for (int i = 0; i < 8; ++i) { const int ch = F.tid + 512 * i, row = ch >> 7, c16 = ch & 127;
            const v4u v = *(const GAS v4u*)(F.P + (size_t)(qrow0 + row) * NPAD + C_IQ + 8 * c16);
            *(LAS v4u*)(F.lds + row * RPQ + 16 * c16) = v; }
        __syncthreads();
        { const int q = F.tid >> 4, d4 = (F.tid & 15) * 4;
          const float* wi = F.WI + (size_t)(qrow0 + q) * 16;
          float a0 = 0.f, a1 = 0.f, a2 = 0.f, a3 = 0.f;
#pragma unroll
          for (int h = 0; h < 16; ++h) { const float w = wi[h]; const v2u x = *(LAS v2u*)(F.lds + q * RPQ + (h * 64 + d4) * 2);
              a0 += w * bflo(x.x); a1 += w * bfhi(x.x); a2 += w * bflo(x.y); a3 += w * bfhi(x.y); }
          v2u o; o.x = cvt2(a0, a1); o.y = cvt2(a2, a3); *(LAS v2u*)(F.lds + q * RPQ + (1024 + d4) * 2) = o;
          wl[q * 17 + (F.tid & 15)] = wi[F.tid & 15]; }
        __syncthreads();
        LAS unsigned char* qb = F.lds + r * RPQ + 16 * hh;
#define IX_LDB(dst, off) do { _Pragma("unroll") for (int s_ = 0; s_ < 4; ++s_) dst[s_] = *(LAS bf16x8*)(qb + (off) + 32 * s_); } while (0)
#define IX_LDA(dst, kt_) do { const bf16* ap_ = F.KIB + (size_t)(b * SEQ + 32 * (kt_) + r) * 64 + 8 * hh; _Pragma("unroll") for (int s_ = 0; s_ < 4; ++s_) dst[s_] = *(const GAS bf16x8*)(ap_ + 16 * s_); } while (0)
        bf16x8 A[4], An[4];
        if (F.wave < nk) IX_LDA(A, kt0 + F.wave);
        for (int kk = F.wave; kk < nk; kk += NWAVES) {
            const int kt = kt0 + kk;
            asm volatile("" ::: "memory");
            if (kk + NWAVES < nk) IX_LDA(An, kt + NWAVES);
            bf16x8 Ba[4], Bb[4];
            IX_LDB(Ba, 2048);
            IX_LDB(Bb, 0);
            f32x16 acc = zero16();
#pragma unroll
            for (int s = 0; s < 4; ++s) acc = MFMA32(A[s], Ba[s], acc);
            f32x16 Ta = zero16(), Tb;
#pragma unroll
            for (int s = 0; s < 4; ++s) Ta = MFMA32(A[s], Bb[s], Ta);
            IX_LDB(Bb, 128);
#define IX_FMA8(T, o, wv) asm volatile("s_nop 1\n\tv_fma_f32 %0, %8, |%9|, %0\n\tv_fma_f32 %1, %8, |%10|, %1\n\tv_fma_f32 %2, %8, |%11|, %2\n\tv_fma_f32 %3, %8, |%12|, %3\n\t" \
                "v_fma_f32 %4, %8, |%13|, %4\n\tv_fma_f32 %5, %8, |%14|, %5\n\tv_fma_f32 %6, %8, |%15|, %6\n\tv_fma_f32 %7, %8, |%16|, %7" \
                : "+v"(acc[o]), "+v"(acc[o + 1]), "+v"(acc[o + 2]), "+v"(acc[o + 3]), "+v"(acc[o + 4]), "+v"(acc[o + 5]), "+v"(acc[o + 6]), "+v"(acc[o + 7]) \
                : "v"(wv), "v"(T[o]), "v"(T[o + 1]), "v"(T[o + 2]), "v"(T[o + 3]), "v"(T[o + 4]), "v"(T[o + 5]), "v"(T[o + 6]), "v"(T[o + 7]))
#pragma unroll 1
            for (int hp = 0; hp < (MODE == 2 ? 1 : 8); ++hp) {
                const float w0 = wl[r * 17 + 2 * hp], w1 = wl[r * 17 + 2 * hp + 1];
                Tb = zero16();
#pragma unroll
                for (int s = 0; s < 4; ++s) Tb = MFMA32(A[s], Bb[s], Tb);
                if (hp < 7) IX_LDB(Ba, (2 * hp + 2) * 128);
                IX_FMA8(Ta, 0, w0); IX_FMA8(Ta, 8, w0);
                Ta = zero16();
                if (hp < 7) {
#pragma unroll
                    for (int s = 0; s < 4; ++s) Ta = MFMA32(A[s], Ba[s], Ta);
                    IX_LDB(Bb, (2 * hp + 3) * 128);
                }
                IX_FMA8(Tb, 0, w1); IX_FMA8(Tb, 8, w1);
            }
#undef IX_FMA8
            { LAS unsigned char* tw = F.lds + 73728 + F.wave * 4608;
#pragma unroll
              for (int g = 0; g < 4; ++g) { const h16x2 p0 = {(_Float16)(acc[4 * g] * 0.015625f), (_Float16)(acc[4 * g + 1] * 0.015625f)}, p1 = {(_Float16)(acc[4 * g + 2] * 0.015625f), (_Float16)(acc[4 * g + 3] * 0.015625f)};
                  v2u o; o.x = __builtin_bit_cast(unsigned, p0); o.y = __builtin_bit_cast(unsigned, p1); *(LAS v2u*)(tw + r * 80 + (8 * g + 4 * hh) * 2) = o; }
              unsigned short* dst = (unsigned short*)F.SC + (size_t)(qrow0 + (lane >> 2)) * SCPH + 32 * kt + 8 * (lane & 3);
#pragma unroll
              for (int i = 0; i < 2; ++i) *(GAS v4u*)(dst + (size_t)(16 * i) * SCPH) = *(LAS v4u*)(tw + ((lane >> 2) + 16 * i) * 80 + (lane & 3) * 16); }
#pragma unroll
            for (int s = 0; s < 4; ++s) A[s] = An[s];
        }
#undef IX_LDB
#undef IX_LDA
    }
    __syncthreads();
}

constexpr int RPK = 320, RPV = 576;
constexpr int ML_KOFF = 0, ML_VOFF = 64 * RPK  , ML_WOFF = ML_VOFF + 64 * RPV  ;
struct MlaRegs { v4u k[2]; v4u v[4]; float ig, lf; };
__device__ __forceinline__ void p2_mlstm_a_load(Frame& F, int unit, MlaRegs& R) {
    const int c = unit & 63, h = (unit >> 6) & 3, b = unit >> 8, row0 = b * SEQ + 64 * c;
    if (F.wave == 0) { R.ig = F.IG[(size_t)(row0 + F.lane) * 4 + h]; R.lf = F.LF[(size_t)(row0 + F.lane) * 4 + h]; }
#pragma unroll
    for (int i = 0; i < 2; ++i) { const int ch = F.tid + 512 * i, s = ch >> 4, c16 = ch & 15; R.k[i] = *(const GAS v4u*)(F.P + (size_t)(row0 + s) * NPAD + C_MK + h * 128 + 8 * c16); }
#pragma unroll
    for (int i = 0; i < 4; ++i) { const int ch = F.tid + 512 * i, s = ch >> 5, c16 = ch & 31; R.v[i] = *(const GAS v4u*)(F.P + (size_t)(row0 + s) * NPAD + C_MV + h * 256 + 8 * c16); }
}
__device__ __forceinline__ void p2_mlstm_a(Frame& F, int unit, const MlaRegs& R, int next_unit, MlaRegs& Rn) {
    const int lane = F.lane, hh = lane >> 5;
    LAS float* wl = (LAS float*)(F.lds + ML_WOFF);
    __syncthreads();
    if (F.wave == 0) {
        float bc = R.lf;
#pragma unroll
        for (int o = 1; o < 64; o <<= 1) { const float t = __shfl_up(bc, o); if (lane >= o) bc += t; }
        const float g = R.ig - bc, G = wave_max(g);
        wl[lane] = __expf(g - G);
        if (lane == 63) { F.CHG[unit] = G; F.CHG[512 + unit] = bc; }
    }
    __syncthreads();
#pragma unroll
    for (int i = 0; i < 2; ++i) { const int ch = F.tid + 512 * i, s = ch >> 4, c16 = ch & 15;
        const v4u v = R.k[i]; const float ws = wl[s];
        v4u o; o.x = cvt2(bflo(v.x) * ws, bfhi(v.x) * ws); o.y = cvt2(bflo(v.y) * ws, bfhi(v.y) * ws); o.z = cvt2(bflo(v.z) * ws, bfhi(v.z) * ws); o.w = cvt2(bflo(v.w) * ws, bfhi(v.w) * ws);
        *(LAS v4u*)(F.lds + ML_KOFF + s * RPK + 16 * c16) = o; }
#pragma unroll
    for (int i = 0; i < 4; ++i) { const int ch = F.tid + 512 * i, s = ch >> 5, c16 = ch & 31;
        *(LAS v4u*)(F.lds + ML_VOFF + s * RPV + 16 * c16) = R.v[i]; }
    if (next_unit >= 0) p2_mlstm_a_load(F, next_unit, Rn);
    __syncthreads();
    if (F.tid < 128) { float a = 0.f;
#pragma unroll 8
        for (int s = 0; s < 64; ++s) a += bf1(*(LAS bf16*)(F.lds + ML_KOFF + s * RPK + 2 * F.tid));
        F.UN[(size_t)unit * 128 + F.tid] = a; }
    const int blk = (lane >> 4) & 1;
    bf16x8 Af[4];
#pragma unroll
    for (int ks = 0; ks < 4; ++ks) Af[ks] = cat8(tr_read4(F.lds + ML_VOFF, 16 * ks + 8 * hh, 32 * F.wave + 16 * blk, RPV, lane), tr_read4(F.lds + ML_VOFF, 16 * ks + 8 * hh + 4, 32 * F.wave + 16 * blk, RPV, lane));
    LAS unsigned char* ut = F.lds + 59392 + F.wave * 8704;
#pragma unroll
    for (int dt = 0; dt < 4; ++dt) {
        f32x16 acc = zero16();
#pragma unroll
        for (int ks = 0; ks < 4; ++ks) {
            const bf16x8 Bf = cat8(tr_read4(F.lds + ML_KOFF, 16 * ks + 8 * hh, 32 * dt + 16 * blk, RPK, lane), tr_read4(F.lds + ML_KOFF, 16 * ks + 8 * hh + 4, 32 * dt + 16 * blk, RPK, lane));
            acc = MFMA32(Af[ks], Bf, acc);
        }
#pragma unroll
        for (int i = 0; i < 16; ++i) *(LAS bf16*)(ut + ((i & 3) + 8 * (i >> 2) + 4 * hh) * 272 + (32 * dt + (lane & 31)) * 2) = (bf16)f2bf(acc[i]);
    }
    bf16* upb = (bf16*)F.UP + (size_t)unit * 32768 + (size_t)(32 * F.wave) * 128;
#pragma unroll
    for (int i = 0; i < 8; ++i) { const int row = (lane >> 4) + 4 * i; *(GAS v4u*)(upb + row * 128 + 8 * (lane & 15)) = *(LAS v4u*)(ut + row * 272 + 16 * (lane & 15)); }
}
constexpr int MA_HALF = 57600;
__device__ __forceinline__ void p2_mlstm_a2(Frame& F, int unitA, int unitB) {
    const int lane = F.lane, hh = lane >> 5, half = F.wave >> 2, hw = F.wave & 3, htid = F.tid & 255;
    const int unit = half ? unitB : unitA; const bool act = unit >= 0; const int uu = act ? unit : 0;
    const int c = uu & 63, h = (uu >> 6) & 3, b = uu >> 8, row0 = b * SEQ + 64 * c;
    LAS unsigned char* LB = F.lds + half * MA_HALF;
    LAS float* wl = (LAS float*)(LB + ML_WOFF);
    float ig = 0.f, lf = 0.f;
    if (hw == 0) { ig = F.IG[(size_t)(row0 + lane) * 4 + h]; lf = F.LF[(size_t)(row0 + lane) * 4 + h]; }
    v4u kr[4], vr[8];
#pragma unroll
    for (int i = 0; i < 4; ++i) { const int ch = htid + 256 * i, s = ch >> 4, c16 = ch & 15; kr[i] = *(const GAS v4u*)(F.P + (size_t)(row0 + s) * NPAD + C_MK + h * 128 + 8 * c16); }
#pragma unroll
    for (int i = 0; i < 8; ++i) { const int ch = htid + 256 * i, s = ch >> 5, c16 = ch & 31; vr[i] = *(const GAS v4u*)(F.P + (size_t)(row0 + s) * NPAD + C_MV + h * 256 + 8 * c16); }
    __syncthreads();
    if (hw == 0) {
        float bc = lf;
#pragma unroll
        for (int o = 1; o < 64; o <<= 1) { const float t = __shfl_up(bc, o); if (lane >= o) bc += t; }
        const float g = ig - bc, G = wave_max(g);
        wl[lane] = __expf(g - G);
        if (lane == 63 && act) { F.CHG[unit] = G; F.CHG[512 + unit] = bc; }
    }
    __syncthreads();
#pragma unroll
    for (int i = 0; i < 4; ++i) { const int ch = htid + 256 * i, s = ch >> 4, c16 = ch & 15;
        const v4u v = kr[i]; const float ws = wl[s];
        v4u o; o.x = cvt2(bflo(v.x) * ws, bfhi(v.x) * ws); o.y = cvt2(bflo(v.y) * ws, bfhi(v.y) * ws); o.z = cvt2(bflo(v.z) * ws, bfhi(v.z) * ws); o.w = cvt2(bflo(v.w) * ws, bfhi(v.w) * ws);
        *(LAS v4u*)(LB + ML_KOFF + s * RPK + 16 * c16) = o; }
#pragma unroll
    for (int i = 0; i < 8; ++i) { const int ch = htid + 256 * i, s = ch >> 5, c16 = ch & 31; *(LAS v4u*)(LB + ML_VOFF + s * RPV + 16 * c16) = vr[i]; }
    __syncthreads();
    if (htid < 128 && act) { float a = 0.f;
#pragma unroll 8
        for (int s = 0; s < 64; ++s) a += bf1(*(LAS bf16*)(LB + ML_KOFF + s * RPK + 2 * htid));
        F.UN[(size_t)unit * 128 + htid] = a; }
    const int blk = (lane >> 4) & 1;
    bf16x8 Af[2][4];
#pragma unroll
    for (int rb = 0; rb < 2; ++rb)
#pragma unroll
        for (int ks = 0; ks < 4; ++ks) Af[rb][ks] = cat8(tr_read4(LB + ML_VOFF, 16 * ks + 8 * hh, 64 * hw + 32 * rb + 16 * blk, RPV, lane), tr_read4(LB + ML_VOFF, 16 * ks + 8 * hh + 4, 64 * hw + 32 * rb + 16 * blk, RPV, lane));
    __syncthreads();
    LAS unsigned char* ut = LB + ML_VOFF + hw * 8704;
#pragma unroll
    for (int rb = 0; rb < 2; ++rb) {
#pragma unroll
        for (int dt = 0; dt < 4; ++dt) {
            f32x16 acc = zero16();
#pragma unroll
            for (int ks = 0; ks < 4; ++ks) {
                const bf16x8 Bf = cat8(tr_read4(LB + ML_KOFF, 16 * ks + 8 * hh, 32 * dt + 16 * blk, RPK, lane), tr_read4(LB + ML_KOFF, 16 * ks + 8 * hh + 4, 32 * dt + 16 * blk, RPK, lane));
                acc = MFMA32(Af[rb][ks], Bf, acc);
            }
#pragma unroll
            for (int i = 0; i < 16; ++i) *(LAS bf16*)(ut + ((i & 3) + 8 * (i >> 2) + 4 * hh) * 272 + (32 * dt + (lane & 31)) * 2) = (bf16)f2bf(acc[i]);
        }
        if (act) { bf16* upb = (bf16*)F.UP + (size_t)unit * 32768 + (size_t)(64 * hw + 32 * rb) * 128;
#pragma unroll
            for (int i = 0; i < 8; ++i) { const int row = (lane >> 4) + 4 * i; *(GAS v4u*)(upb + row * 128 + 8 * (lane & 15)) = *(LAS v4u*)(ut + row * 272 + 16 * (lane & 15)); } }
    }
}
__device__ __forceinline__ void p2_mlstm_a_all(Frame& F) {
    for (int u = blockIdx.x; u < 512; u += 2 * F.G) p2_mlstm_a2(F, u, (u + F.G < 512) ? u + F.G : -1);
    __syncthreads();
}

__device__ __forceinline__ void p2_sample_scores(Frame& F) {
    const int lane = F.lane, c = lane & 31, hh = lane >> 5;
    const int nsw = (F.G == 256) ? P2_NS : F.G;
    if ((int)blockIdx.x >= nsw) return;
    const int gw = blockIdx.x * NWAVES + F.wave, NGW = nsw * NWAVES;
    for (int task = gw; task < MS * NPAGES; task += NGW) {
        const int s = task >> 7, pg = task & 127;
        bf16x8 qB[4];
        { const bf16* qp = F.P + (size_t)(MP + s) * NPAD + C_IQ + (c & 15) * 64 + 8 * hh;
#pragma unroll
          for (int k = 0; k < 4; ++k) { const v4u x = *(const GAS v4u*)(qp + 16 * k); qB[k] = __builtin_bit_cast(bf16x8, (c < 16) ? x : (v4u){0u, 0u, 0u, 0u}); } }
        const float w = (c < 16) ? F.WI[(size_t)(MP + s) * 16 + (c & 15)] : 0.f;
        const int page = F.page_table[s * NPAGES + pg];
        const float* pb = F.cache_ik + (size_t)page * PAGE * 64 + 4 * lane;
        LAS unsigned char* wb = F.lds + F.wave * 8704;
        f32x4 Ac[8], An[8];
#pragma unroll
        for (int i = 0; i < 8; ++i) Ac[i] = __builtin_nontemporal_load((const GAS f32x4*)(pb + 256 * i));
#pragma unroll 1
        for (int kb = 0; kb < 4; ++kb) {
            if (kb < 3) {
#pragma unroll
                for (int i = 0; i < 8; ++i) An[i] = __builtin_nontemporal_load((const GAS f32x4*)(pb + (kb + 1) * 2048 + 256 * i)); }
#pragma unroll
            for (int i = 0; i < 8; ++i) *(LAS f32x4*)(wb + (4 * i + (lane >> 4)) * 272 + (lane & 15) * 16) = Ac[i];
            f32x16 acc = zero16();
#pragma unroll
            for (int k = 0; k < 4; ++k) { const f32x4 a0 = *(LAS f32x4*)(wb + c * 272 + (16 * k + 8 * hh) * 4), a1 = *(LAS f32x4*)(wb + c * 272 + (16 * k + 8 * hh) * 4 + 16);
                v4u a; a.x = cvt2(a0.x, a0.y); a.y = cvt2(a0.z, a0.w); a.z = cvt2(a1.x, a1.y); a.w = cvt2(a1.z, a1.w);
                acc = MFMA32(__builtin_bit_cast(bf16x8, a), qB[k], acc); }
#pragma unroll
            for (int i = 0; i < 16; ++i) acc[i] = row16_sum(w * fmaxf(acc[i], 0.f));
            if (c == 0) { float* dst = F.SS + (size_t)s * SSP + pg * PAGE + 32 * kb + 4 * hh;
#pragma unroll
                for (int g = 0; g < 4; ++g) *(f32x4*)(dst + 8 * g) = (f32x4){acc[4 * g], acc[4 * g + 1], acc[4 * g + 2], acc[4 * g + 3]}; }
#pragma unroll
            for (int j = 0; j < 8; ++j) Ac[j] = An[j];
        }
        if (pg == 0) {
            const float kn = F.out[O_IKS + (size_t)s * 64 + lane];
            const bf16* qp = F.P + (size_t)(MP + s) * NPAD + C_IQ;
            float sc = 0.f;
#pragma unroll
            for (int h = 0; h < 16; ++h) { const float a = wave_sum(bf1(qp[h * 64 + lane]) * bf1((bf16)f2bf(kn))); sc += F.WI[(size_t)(MP + s) * 16 + h] * fmaxf(a, 0.f); }
            if (lane == 0) F.SS[(size_t)s * SSP + PAST] = sc;
        }
    }
}

__device__ __forceinline__ void p2_phase(Frame& F) {
    REPEAT(21) { REP_BAR(); p2_sample_scores(F); REP_BAR(); }
    REPEAT(22) { REP_BAR(); p2_mlstm_a_all(F); REP_BAR(); }
    REPEAT(23) { REP_BAR(); p2_indexer<0>(F); REP_BAR(); }
}
__device__ __forceinline__ unsigned fkey(float f) { const unsigned u = __builtin_bit_cast(unsigned, f); return (u & 0x80000000u) ? ~u : (u | 0x80000000u); }
#define CNT8(c0, c1, c2, c3, u, o, cand) do { unsigned long long t0_, t1_, t2_, t3_, t4_, t5_, t6_, t7_; \
  asm volatile("v_cmp_ge_u32_e64 %4, %12, %20\n\tv_cmp_ge_u32_e64 %5, %13, %20\n\tv_cmp_ge_u32_e64 %6, %14, %20\n\tv_cmp_ge_u32_e64 %7, %15, %20\n\t" \
               "v_cmp_ge_u32_e64 %8, %16, %20\n\tv_cmp_ge_u32_e64 %9, %17, %20\n\tv_cmp_ge_u32_e64 %10, %18, %20\n\tv_cmp_ge_u32_e64 %11, %19, %20\n\t" \
               "v_addc_co_u32_e64 %0, %4, %0, 0, %4\n\tv_addc_co_u32_e64 %1, %5, %1, 0, %5\n\tv_addc_co_u32_e64 %2, %6, %2, 0, %6\n\tv_addc_co_u32_e64 %3, %7, %3, 0, %7\n\t" \
               "v_addc_co_u32_e64 %0, %8, %0, 0, %8\n\tv_addc_co_u32_e64 %1, %9, %1, 0, %9\n\tv_addc_co_u32_e64 %2, %10, %2, 0, %10\n\tv_addc_co_u32_e64 %3, %11, %3, 0, %11" \
    : "+v"(c0), "+v"(c1), "+v"(c2), "+v"(c3), "=&s"(t0_), "=&s"(t1_), "=&s"(t2_), "=&s"(t3_), "=&s"(t4_), "=&s"(t5_), "=&s"(t6_), "=&s"(t7_) \
    : "v"(u[o]), "v"(u[(o) + 1]), "v"(u[(o) + 2]), "v"(u[(o) + 3]), "v"(u[(o) + 4]), "v"(u[(o) + 5]), "v"(u[(o) + 6]), "v"(u[(o) + 7]), "s"(cand)); } while (0)
template <int J, unsigned M> __device__ __forceinline__ void bt_stage(unsigned (&A)[32]) {
#pragma unroll
    for (int k0 = 0; k0 < 16; ++k0) { const int k = (k0 & (J - 1)) | ((k0 & ~(J - 1)) << 1);
        const unsigned t = (A[k] ^ (A[k + J] >> J)) & M; A[k] ^= t; A[k + J] ^= (t << J); }
}
__device__ __forceinline__ void bt32(unsigned (&A)[32]) { bt_stage<16, 0x0000FFFFu>(A); bt_stage<8, 0x00FF00FFu>(A); bt_stage<4, 0x0F0F0F0Fu>(A); bt_stage<2, 0x33333333u>(A); bt_stage<1, 0x55555555u>(A); }
__device__ __forceinline__ void p3_select_load(Frame& F, int b, int pos, unsigned (&v)[32]) {
    const int lane = F.lane, ngl = (((pos + 128) >> 7) + 7) >> 3;
    const unsigned* src = (const unsigned*)((const unsigned short*)F.SC + (size_t)(b * SEQ + pos) * SCPH) + lane;
#pragma unroll
    for (int g = 0; g < 4; ++g) {
        if (g < ngl) {
#pragma unroll
            for (int k = 0; k < 8; ++k) v[8 * g + k] = src[64 * (8 * g + k)];
        } else {
#pragma unroll
            for (int k = 0; k < 8; ++k) v[8 * g + k] = 0u;
        }
    }
}
__device__ __forceinline__ void p3_select_put(Frame& F, int pos, const unsigned (&v)[32]) {
    const int lane = F.lane, ngl = (((pos + 128) >> 7) + 7) >> 3;
    LAS unsigned* wl = (LAS unsigned*)(F.lds + F.wave * 17408) + lane;
#pragma unroll
    for (int g = 0; g < 4; ++g) if (g < ngl) {
#pragma unroll
        for (int k = 0; k < 8; ++k) { const int i = 8 * g + k, k0 = 128 * i + 2 * lane; const unsigned x = v[i];
            const unsigned key = x ^ ((((x >> 15) & 0x00010001u) * 0xFFFFu) | 0x80008000u);
            wl[i * 68] = key & ((k0 <= pos ? 0x0000FFFFu : 0u) | (k0 + 1 <= pos ? 0xFFFF0000u : 0u)); } }
}
__device__ __forceinline__ unsigned spread16(unsigned x) { x &= 0xFFFFu; x = (x | (x << 8)) & 0x00FF00FFu; x = (x | (x << 4)) & 0x0F0F0F0Fu; x = (x | (x << 2)) & 0x33333333u; return (x | (x << 1)) & 0x55555555u; }
__device__ __forceinline__ void p3_select_row(Frame& F, int b, int pos) {
    const int lane = F.lane;
    const int n = pos + 1, nc = (n + 127) >> 7;
    unsigned* dst = F.BMT + ((size_t)(b * 128 + 2 * lane)) * BMP + pos;
    if (n <= 256) {
        const int nv = n - 64 * lane;
        const unsigned lo = nv >= 32 ? 0xFFFFFFFFu : (nv > 0 ? (1u << nv) - 1u : 0u), hi = nv >= 64 ? 0xFFFFFFFFu : (nv > 32 ? (1u << (nv - 32)) - 1u : 0u);
        dst[0] = lo; dst[BMP] = hi; return;
    }
    unsigned A[32];
    { const int ci = lane >> 1; const bool ok = ci < nc;
      const LAS v4u* rp = (const LAS v4u*)((LAS unsigned*)(F.lds + F.wave * 17408) + (ok ? ci : 0) * 68 + 32 * (lane & 1));
#pragma unroll
      for (int c = 0; c < 8; ++c) { const v4u x = rp[c];
          A[31 - 4 * c] = ok ? x.x : 0u; A[30 - 4 * c] = ok ? x.y : 0u; A[29 - 4 * c] = ok ? x.z : 0u; A[28 - 4 * c] = ok ? x.w : 0u; } }
    bt32(A);
    unsigned eq_e = 0xFFFFFFFFu, eq_o = 0xFFFFFFFFu, gt_e = 0u, gt_o = 0u; int above = 0;
#pragma unroll
    for (int bit = 15; bit >= 0; --bit) {
        const unsigned al = eq_e & A[31 - bit], ah = eq_o & A[15 - bit];
        const int tot = wave_sum_i(__builtin_popcount(al) + __builtin_popcount(ah));
        const bool take = (above + tot) >= 256;
        const unsigned x = take ? 0u : 0xFFFFFFFFu;
        gt_e |= al & x; gt_o |= ah & x;
        eq_e &= A[31 - bit] ^ x; eq_o &= A[15 - bit] ^ x;
        above += take ? 0 : tot;
    }
    const int need = 256 - above, pc = __builtin_popcount(eq_e) + __builtin_popcount(eq_o), ce = wave_sum_i(pc);
    unsigned sel_lo = spread16(gt_e | eq_e) | (spread16(gt_o | eq_o) << 1), sel_hi = spread16((gt_e | eq_e) >> 16) | (spread16((gt_o | eq_o) >> 16) << 1);
    if (ce != need) {
        int inc = pc;
#pragma unroll
        for (int o = 1; o < 64; o <<= 1) { const int t = __shfl_up(inc, o); if (lane >= o) inc += t; }
        int kt = need - (inc - pc); kt = kt < 0 ? 0 : (kt > pc ? pc : kt);
        unsigned long long e = ((unsigned long long)(spread16(eq_e >> 16) | (spread16(eq_o >> 16) << 1)) << 32) | (spread16(eq_e) | (spread16(eq_o) << 1)), s = 0ull;
        for (int i = 0; i < kt; ++i) { const unsigned long long low = e & (0ull - e); s |= low; e ^= low; }
        sel_lo = (spread16(gt_e) | (spread16(gt_o) << 1)) | (unsigned)s; sel_hi = (spread16(gt_e >> 16) | (spread16(gt_o >> 16) << 1)) | (unsigned)(s >> 32);
    }
    dst[0] = sel_lo; dst[BMP] = sel_hi;
}
__device__ __forceinline__ void p3_select(Frame& F) {
    const int skip = (F.G > 2 * MS) ? MS : 0;
    const int gw = ((int)blockIdx.x - skip) * NWAVES + F.wave, NGW = (F.G - skip) * NWAVES;
    const int nrows = (gw >= 0 && gw < MP / 2) ? 2 * ((MP / 2 - 1 - gw) / NGW + 1) : 0;
    unsigned va[32];
    if (nrows > 0) p3_select_load(F, gw >> 11, gw & 2047, va);
#pragma unroll 1
    for (int j = 0; j < nrows; ++j) {
        const int t0 = gw + (j >> 1) * NGW, b0 = t0 >> 11, p0 = (j & 1) ? SEQ - 1 - (t0 & 2047) : (t0 & 2047);
        p3_select_put(F, p0, va);
        if (j + 1 < nrows) { const int t1 = gw + ((j + 1) >> 1) * NGW; p3_select_load(F, t1 >> 11, ((j + 1) & 1) ? SEQ - 1 - (t1 & 2047) : (t1 & 2047), va); }
        p3_select_row(F, b0, p0);
    }
}
__device__ __forceinline__ void p3_scan(Frame& F) {
    const int NGT = F.G * NTHR;
    LAS float* tab = (LAS float*)F.lds;
    for (int t0 = blockIdx.x * NTHR; t0 < 8 * 16384; t0 += NGT) {
        const int bh = t0 >> 14;
        const int e4 = ((t0 & 16383) * 2) + 4 * F.tid;
        const bf16* up = (const bf16*)F.UP + (size_t)bh * 64 * 32768 + e4; bf16* cs = F.CST + (size_t)bh * 64 * 32768 + e4;
#define SCAN_LD(dst, cb_) do { _Pragma("unroll") for (int k = 0; k < 16; ++k) dst[k] = *(const GAS v2u*)(up + (size_t)((cb_) + k) * 32768); } while (0)
#define SCAN_DO(src, cb_) do { _Pragma("unroll") for (int k = 0; k < 16; ++k) { const int c = (cb_) + k; \
                    v2u o_; o_.x = cvt2(c0, c1); o_.y = cvt2(c2, c3); *(GAS v2u*)(cs + (size_t)c * 32768) = o_; \
                    const f32x2 ab = *(LAS f32x2*)(tab + 2 * c); \
                    c0 = ab.x * c0 + ab.y * bflo(src[k].x); c1 = ab.x * c1 + ab.y * bfhi(src[k].x); c2 = ab.x * c2 + ab.y * bflo(src[k].y); c3 = ab.x * c3 + ab.y * bfhi(src[k].y); } } while (0)
        v2u ua[16], ub[16];
        if (F.tid < 256) { SCAN_LD(ua, 0); SCAN_LD(ub, 16); }
        __syncthreads();
        if (F.tid < 64) { tab[128 + F.tid] = F.CHG[bh * 64 + F.tid]; tab[192 + F.tid] = F.CHG[512 + bh * 64 + F.tid]; }
        __syncthreads();
        if (F.tid == 0) { float m = 0.f;
#pragma unroll
            for (int c = 0; c < 64; ++c) { tab[256 + c] = m; m = tab[192 + c] + fmaxf(m, tab[128 + c]); } }
        __syncthreads();
        if (F.tid < 64) { const float m = tab[256 + F.tid], G = tab[128 + F.tid], M = fmaxf(m, G); tab[2 * F.tid] = __expf(m - M); tab[2 * F.tid + 1] = __expf(G - M); }
        __syncthreads();
        if (F.tid < 256) {
            float c0 = 0.f, c1 = 0.f, c2 = 0.f, c3 = 0.f;
            SCAN_DO(ua, 0); SCAN_LD(ua, 32);
            SCAN_DO(ub, 16); SCAN_LD(ub, 48);
            SCAN_DO(ua, 32); SCAN_DO(ub, 48);
            *(GAS f32x4*)(F.out + O_CP + (size_t)bh * 32768 + e4) = (f32x4){c0, c1, c2, c3};
        }
#undef SCAN_LD
#undef SCAN_DO
    }
    if ((int)blockIdx.x == ((F.G > 2 * MS) ? MS - 1 : F.G - 1)) {
        const int r = F.tid, bh2 = r >> 6, d2 = (r & 63) * 2;
        float m = 0.f, n0 = 0.f, n1 = 0.f;
        const float* gp = F.CHG + bh2 * 64;
#pragma unroll 1
        for (int cb = 0; cb < 64; cb += 16) {
            float Gs[16], Bs[16]; f32x2 un[16];
#pragma unroll
            for (int k = 0; k < 16; ++k) { Gs[k] = gp[cb + k]; Bs[k] = gp[512 + cb + k]; un[k] = *(const GAS f32x2*)(F.UN + (size_t)(bh2 * 64 + cb + k) * 128 + d2); }
#pragma unroll
            for (int k = 0; k < 16; ++k) { const int c = cb + k;
                *(GAS f32x2*)(F.NST + (size_t)(bh2 * 64 + c) * 128 + d2) = (f32x2){n0, n1};
                if (d2 == 0) F.MST[bh2 * 64 + c] = m;
                const float G = Gs[k], B = Bs[k], M = fmaxf(m, G), al = __expf(m - M), be = __expf(G - M);
                n0 = al * n0 + be * un[k].x; n1 = al * n1 + be * un[k].y; m = B + M; }
        }
        *(GAS f32x2*)(F.out + O_NP + (size_t)bh2 * 128 + d2) = (f32x2){n0, n1};
        if (d2 == 0) F.out[O_MPR + bh2] = m;
    }
    __syncthreads();
}
__device__ __forceinline__ int block_sum(Frame& F, int v, LAS int* red, int par) {
    const int w = wave_sum_i(v);
    if (F.lane == 0) red[par * 8 + F.wave] = w;
    __syncthreads();
    int s = 0;
#pragma unroll
    for (int i = 0; i < NWAVES; ++i) s += red[par * 8 + i];
    return s;
}
__device__ __forceinline__ int block_excl_scan(Frame& F, int v, LAS int* red) {
    int inc = v;
#pragma unroll
    for (int o = 1; o < 64; o <<= 1) { const int t = __shfl_up(inc, o); if (F.lane >= o) inc += t; }
    __syncthreads();
    if (F.lane == 63) red[F.wave] = inc;
    __syncthreads();
    int base = 0;
#pragma unroll
    for (int i = 0; i < NWAVES; ++i) if (i < F.wave) base += red[i];
    return base + inc - v;
}
__device__ __forceinline__ void p3_sample_select(Frame& F, int s) {
    constexpr int PER = 33;
    LAS unsigned* ul = (LAS unsigned*)F.lds;
    LAS int* red = (LAS int*)(F.lds + 16896 * 4);
    __syncthreads();
    { const GAS float* ss = (const GAS float*)(F.SS + (size_t)s * SSP);
      float sv[PER];
#pragma unroll
      for (int k = 0; k < PER; ++k) { const int i = F.tid + NTHR * k; sv[k] = ss[i < LS ? i : LS - 1]; }
#pragma unroll
      for (int k = 0; k < PER; ++k) { const int i = F.tid + NTHR * k; ul[i] = (i < LS) ? fkey(sv[k]) : 0u; } }
    __syncthreads();
    unsigned u[PER];
#pragma unroll
    for (int i = 0; i < PER; ++i) u[i] = ul[F.tid * PER + i];
    unsigned A[32];
#pragma unroll
    for (int i = 0; i < 32; ++i) A[i] = u[31 - i];
    bt32(A);
    const unsigned ux = u[32];
    unsigned eq = 0xFFFFFFFFu, thr = 0u; bool eqx = true; int above = 0;
#pragma unroll
    for (int it = 0; it < 16; ++it) {
        const int b0 = 30 - 2 * it;
        const unsigned P1 = A[2 * it], P0 = A[2 * it + 1];
        const unsigned m11 = eq & P1 & P0, m10 = eq & P1 & ~P0, m01 = eq & ~P1 & P0;
        const unsigned dx = (ux >> b0) & 3u;
        const int c11 = __builtin_popcount(m11) + ((eqx && dx == 3u) ? 1 : 0), c10 = __builtin_popcount(m10) + ((eqx && dx == 2u) ? 1 : 0), c01 = __builtin_popcount(m01) + ((eqx && dx == 1u) ? 1 : 0);
        const int w0 = wave_sum_i(c11 | (c10 << 16)), w1 = wave_sum_i(c01);
        LAS int* rp = red + (it & 1) * 16;
        if (F.lane == 0) { rp[F.wave] = w0; rp[8 + F.wave] = w1; }
        __syncthreads();
        int s0 = 0, s1 = 0;
#pragma unroll
        for (int i = 0; i < NWAVES; ++i) { s0 += rp[i]; s1 += rp[8 + i]; }
        s0 = __builtin_amdgcn_readfirstlane(s0); s1 = __builtin_amdgcn_readfirstlane(s1);
        const int S11 = s0 & 0xFFFF, S10 = s0 >> 16, S01 = s1;
        unsigned d;
        if (above + S11 >= 256) d = 3u;
        else if (above + S11 + S10 >= 256) { d = 2u; above += S11; }
        else if (above + S11 + S10 + S01 >= 256) { d = 1u; above += S11 + S10; }
        else { d = 0u; above += S11 + S10 + S01; }
        eq = d == 3u ? m11 : (d == 2u ? m10 : (d == 1u ? m01 : (eq & ~P1 & ~P0)));
        eqx = eqx && (dx == d);
        thr |= d << b0;
    }
    int cg = 0, ce = 0;
#pragma unroll
    for (int i = 0; i < PER; ++i) { cg += (u[i] > thr) ? 1 : 0; ce += (u[i] == thr) ? 1 : 0; }
    __syncthreads();
    const int need = 256 - block_sum(F, cg, red, 0);
    const int ebase = block_excl_scan(F, ce, red + 64);
    int csel = 0, er = ebase;
    unsigned long long selm = 0ull;
#pragma unroll
    for (int i = 0; i < PER; ++i) { bool sel = u[i] > thr; if (u[i] == thr) { sel = er < need; ++er; } if (sel) { selm |= 1ull << i; ++csel; } }
    int pos = block_excl_scan(F, csel, red + 96);
#pragma unroll
    for (int i = 0; i < PER; ++i) if ((selm >> i) & 1ull) { if (pos < 256) F.SIDX[s * 256 + pos] = F.tid * PER + i; ++pos; }
}
__device__ __forceinline__ void p3_phase(Frame& F) {
    REPEAT(31) { REP_BAR(); for (int s = blockIdx.x; s < MS; s += F.G) p3_sample_select(F, s); REP_BAR(); }
    if ((blockIdx.x & 1) && DUP_SUB == 0) { p3_select(F); __syncthreads(); p3_scan(F); }
    else {
    REPEAT(32) { REP_BAR(); p3_scan(F); REP_BAR(); }
    p3_select(F);
    }
}
constexpr int RPAK = 272, RPAV = 320;
constexpr int AT_MOFF = 128 * RPAK + 128 * RPAV, AT_BUF = AT_MOFF + 4096;
__device__ __forceinline__ void p4_attn_unit(Frame& F, int unit) {
    const int lane = F.lane, r = lane & 31, hh = lane >> 5, blk = (lane >> 4) & 1;
    const int qb = unit & 127, kvh = (unit >> 7) & 1, b = unit >> 8;
    const int hq = kvh * 4 + (F.wave & 3), kh = F.wave >> 2, q = 32 * qb + r;
    const int nt = (qb >> 2) + 1;
    const size_t qrow = (size_t)(b * SEQ + q);
    bf16x8 Qf[8];
#pragma unroll
    for (int s = 0; s < 8; ++s) Qf[s] = *(const GAS bf16x8*)(F.P + qrow * NPAD + C_Q + hq * 128 + 16 * s + 8 * hh);
    f32x16 O[4];
#pragma unroll
    for (int c = 0; c < 4; ++c) O[c] = zero16();
    float m = -INFINITY, l = 0.f;
    const int srow = F.tid >> 4, sc16 = F.tid & 15;
    v4u kreg[4], vreg[4]; unsigned mreg;
    const int mg16 = F.tid >> 5, mrq = F.tid & 31;
    const unsigned* mbase = F.BMT + (size_t)(b * 128 + 2 * (mg16 >> 3) + ((mg16 >> 2) & 1)) * BMP + 32 * qb + mrq;
    const int msh = 4 * ((mg16 >> 1) & 1) + 16 * (mg16 & 1), moff = AT_MOFF + ((mg16 >> 2) * 32 + mrq) * 32 + ((mg16 >> 1) & 1) * 16 + 8 * (mg16 & 1);
    const bf16* kbase = F.KVC + (size_t)((b * 2 + kvh) * SEQ) * 256 + 8 * sc16;
    const bf16* vbase = kbase + 128;
#define AT_LOAD(t) do { _Pragma("unroll") for (int i = 0; i < 4; ++i) { const size_t ro = (size_t)(128 * (t) + srow + 32 * i) * 256; kreg[i] = *(const GAS v4u*)(kbase + ro); vreg[i] = *(const GAS v4u*)(vbase + ro); } mreg = mbase[(size_t)(4 * (t)) * BMP]; } while (0)
#define AT_STORE(buf) do { _Pragma("unroll") for (int i = 0; i < 4; ++i) { *(LAS v4u*)(F.lds + (buf) * AT_BUF + (srow + 32 * i) * RPAK + 16 * sc16) = kreg[i]; \
        *(LAS v4u*)(F.lds + (buf) * AT_BUF + 128 * RPAK + (srow + 32 * i) * RPAV + 16 * sc16) = vreg[i]; } \
        { const unsigned n0_ = (mreg >> msh) & 0xFu, n1_ = (mreg >> (msh + 8)) & 0xFu; v2u mm_; mm_.x = ((n0_ * 0x00204081u) & 0x01010101u) * 0xFFu; mm_.y = ((n1_ * 0x00204081u) & 0x01010101u) * 0xFFu; \
          *(LAS v2u*)(F.lds + (buf) * AT_BUF + moff) = mm_; } } while (0)
    __syncthreads();
    AT_LOAD(0); AT_STORE(0);
    if (nt > 1) AT_LOAD(1);
    __syncthreads();
    for (int t = 0; t < nt; ++t) {
        const int buf = t & 1;
        if (t + 1 < nt) AT_STORE(buf ^ 1);
        LAS unsigned char* kl = F.lds + buf * AT_BUF + (64 * kh) * RPAK; LAS unsigned char* vl = F.lds + buf * AT_BUF + 128 * RPAK + (64 * kh) * RPAV;
        f32x16 X[2];
        {
            bf16x8 Kf[16];
#define AT_KF(i) (*(LAS bf16x8*)(kl + (32 * ((i) >> 3) + r) * RPAK + (16 * ((i) & 7) + 8 * hh) * 2))
#pragma unroll
            for (int i = 0; i < 4; ++i) Kf[i] = AT_KF(i);
            __builtin_amdgcn_sched_barrier(0);
            X[0] = zero16(); X[1] = zero16();
#pragma unroll
            for (int i = 0; i < 16; ++i) { if (i + 4 < 16) Kf[i + 4] = AT_KF(i + 4); X[i >> 3] = MFMA32(Kf[i], Qf[i & 7], X[i >> 3]); __builtin_amdgcn_sched_barrier(0); }
#undef AT_KF
        }
        __builtin_amdgcn_sched_barrier(0);
        if (t + 2 < nt) AT_LOAD(t + 2);
        LAS unsigned char* ml = F.lds + buf * AT_BUF + AT_MOFF + ((2 * kh) * 32 + r) * 32 + hh * 16;
        const v4u mk0 = *(LAS v4u*)ml, mk1 = *(LAS v4u*)(ml + 1024);
        float tmax = fmaxf(X[0][0], X[1][0]);
#pragma unroll
        for (int i = 1; i < 16; ++i) tmax = fmaxf(tmax, fmaxf(X[0][i], X[1][i]));
        tmax = xhalf_max(tmax);
        const float mn = fmaxf(m, tmax);
        const float alpha = __builtin_amdgcn_exp2f((m - mn) * ATT_C), msc = mn * ATT_C;
        m = mn;
        float ps = 0.f;
        bf16x8 Pf[2][2];
#pragma unroll
        for (int sb = 0; sb < 2; ++sb) {
            const v4u mk = sb ? mk1 : mk0;
#pragma unroll
            for (int i = 0; i < 16; ++i) X[sb][i] = __builtin_amdgcn_exp2f(__builtin_fmaf(X[sb][i], ATT_C, -msc));
#pragma unroll
            for (int s2 = 0; s2 < 2; ++s2) { v4u pk;
#pragma unroll
                for (int jj = 0; jj < 4; ++jj) { const int j = 4 * s2 + jj;
                    const unsigned mw = __builtin_amdgcn_perm(mk[j >> 1], mk[j >> 1], (j & 1) ? 0x03030202u : 0x01010000u);
                    const unsigned pw = cvt2(X[sb][2 * j], X[sb][2 * j + 1]) & mw;
                    ps = __builtin_amdgcn_fdot2_f32_bf16(__builtin_bit_cast(bf16x2_t, pw), __builtin_bit_cast(bf16x2_t, 0x3F803F80u), ps, false);
                    pk[jj] = pw; }
                Pf[sb][s2] = __builtin_bit_cast(bf16x8, pk); }
        }
        l = l * alpha + ps;
#pragma unroll
        for (int c = 0; c < 4; ++c)
#pragma unroll
            for (int i = 0; i < 16; ++i) O[c][i] *= alpha;
#pragma unroll
        for (int sb = 0; sb < 2; ++sb)
#pragma unroll
            for (int s2 = 0; s2 < 2; ++s2)
#pragma unroll
                for (int c = 0; c < 4; ++c) {
                    const bf16x8 Vf = cat8(tr_read4(vl, 32 * sb + 16 * s2 + 4 * hh, 32 * c + 16 * blk, RPAV, lane), tr_read4(vl, 32 * sb + 16 * s2 + 8 + 4 * hh, 32 * c + 16 * blk, RPAV, lane));
                    O[c] = MFMA32(Vf, Pf[sb][s2], O[c]);
                }
        __syncthreads();
    }
#undef AT_LOAD
#undef AT_STORE
    LAS float* mg = (LAS float*)F.lds + (size_t)(F.wave & 3) * 66 * 64 + lane;
    if (kh == 1) {
#pragma unroll
        for (int c = 0; c < 4; ++c)
#pragma unroll
            for (int i = 0; i < 16; ++i) mg[(16 * c + i) * 64] = O[c][i];
        mg[64 * 64] = m; mg[65 * 64] = l;
    }
    __syncthreads();
    if (kh == 0) {
        const float m1 = mg[64 * 64], l1 = mg[65 * 64];
        const float mn = fmaxf(m, m1);
        const float a0 = __builtin_amdgcn_exp2f((m - mn) * ATT_C), a1 = __builtin_amdgcn_exp2f((m1 - mn) * ATT_C);
        l = l * a0 + l1 * a1;
        l = xhalf_sum(l);
        const float inv = __builtin_amdgcn_rcpf(l);
        LAS unsigned char* ot = F.lds + AT_BUF + r * 2064 + (F.wave & 3) * 512;
#pragma unroll
        for (int c = 0; c < 4; ++c)
#pragma unroll
            for (int g = 0; g < 4; ++g) { f32x4 o;
#pragma unroll
                for (int jj = 0; jj < 4; ++jj) o[jj] = (O[c][4 * g + jj] * a0 + mg[(16 * c + 4 * g + jj) * 64] * a1) * inv;
                *(LAS f32x4*)(ot + (32 * c + 8 * g + 4 * hh) * 4) = o; }
    }
    __syncthreads();
    {
        const int ck = F.tid & 63;
        v4u az[4];
#pragma unroll
        for (int i = 0; i < 4; ++i) az[i] = *(const GAS v4u*)(F.P + (size_t)(b * SEQ + 32 * qb + (F.tid >> 6) + 8 * i) * NPAD + C_AZ + kvh * 512 + 8 * ck);
#pragma unroll
        for (int i = 0; i < 4; ++i) { const int qq = (F.tid >> 6) + 8 * i;
            const f32x4 h0 = *(LAS f32x4*)(F.lds + AT_BUF + qq * 2064 + 32 * ck), h1 = *(LAS f32x4*)(F.lds + AT_BUF + qq * 2064 + 32 * ck + 16);
            v4u o;
            o.x = cvt2(h0.x * siluf_(bflo(az[i].x)), h0.y * siluf_(bfhi(az[i].x))); o.y = cvt2(h0.z * siluf_(bflo(az[i].y)), h0.w * siluf_(bfhi(az[i].y)));
            o.z = cvt2(h1.x * siluf_(bflo(az[i].z)), h1.y * siluf_(bfhi(az[i].z))); o.w = cvt2(h1.z * siluf_(bflo(az[i].w)), h1.w * siluf_(bfhi(az[i].w)));
            *(GAS v4u*)(F.MIX + (size_t)(b * SEQ + 32 * qb + qq) * DM + kvh * 512 + 8 * ck) = o; }
    }
}

constexpr int RPQK = 272;
constexpr int MC_QOFF = 0, MC_KOFF = 64 * RPQK, MC_VOFF = 2 * 64 * RPQK  , MC_TOFF = MC_VOFF + 64 * RPV  ;
struct MlcRegs { v4u q[2]; v4u k[2]; v4u v[4]; float ig, lf, m0; };
__device__ __forceinline__ void p4_mlstm_c_load(Frame& F, int unit, MlcRegs& R) {
    const int c = unit & 63, h = (unit >> 6) & 3, b = unit >> 8, row0 = b * SEQ + 64 * c;
    R.m0 = F.MST[unit];
    if (F.wave == 0) { R.ig = F.IG[(size_t)(row0 + F.lane) * 4 + h]; R.lf = F.LF[(size_t)(row0 + F.lane) * 4 + h]; }
#pragma unroll
    for (int i = 0; i < 2; ++i) { const int ch = F.tid + 512 * i, s = ch >> 4, c16 = ch & 15;
        R.q[i] = *(const GAS v4u*)(F.P + (size_t)(row0 + s) * NPAD + C_MQ + h * 128 + 8 * c16); R.k[i] = *(const GAS v4u*)(F.P + (size_t)(row0 + s) * NPAD + C_MK + h * 128 + 8 * c16); }
#pragma unroll
    for (int i = 0; i < 4; ++i) { const int ch = F.tid + 512 * i, s = ch >> 5, c16 = ch & 31; R.v[i] = *(const GAS v4u*)(F.P + (size_t)(row0 + s) * NPAD + C_MV + h * 256 + 8 * c16); }
}
__device__ __forceinline__ void p4_mlstm_c(Frame& F, int unit, const MlcRegs& R, int next_unit, MlcRegs& Rn) {
    const int lane = F.lane, r = lane & 31, hh = lane >> 5, blk = (lane >> 4) & 1;
    const int c = unit & 63, h = (unit >> 6) & 3, b = unit >> 8;
    const int row0 = b * SEQ + 64 * c;
    LAS float* tg = (LAS float*)(F.lds + MC_TOFF); LAS float* tM = tg + 64; LAS float* ta = tg + 128; LAS float* tb = tg + 192; LAS float* tnq = tg + 256; LAS float* tss = tg + 384;
    const float m0 = R.m0;
    const int tt = F.wave & 1, vg = F.wave >> 1;
    const bf16* cst = F.CST + (size_t)unit * 32768;
    bf16x8 Cf[2][8];
#pragma unroll
    for (int ks = 0; ks < 8; ++ks) Cf[0][ks] = *(const GAS bf16x8*)(cst + (size_t)(32 * vg + r) * 128 + 16 * ks + 8 * hh);
    float nreg[16];
    { const GAS f32x4* np4 = (const GAS f32x4*)(F.NST + (size_t)unit * 128 + 16 * (F.tid >> 6));
#pragma unroll
      for (int i = 0; i < 4; ++i) { const f32x4 t4 = np4[i]; nreg[4 * i] = t4.x; nreg[4 * i + 1] = t4.y; nreg[4 * i + 2] = t4.z; nreg[4 * i + 3] = t4.w; } }
    __syncthreads();
    if (F.wave == 0) {
        float bc = R.lf;
#pragma unroll
        for (int o = 1; o < 64; o <<= 1) { const float t = __shfl_up(bc, o); if (lane >= o) bc += t; }
        const float g = R.ig - bc;
        float cm = g;
#pragma unroll
        for (int o = 1; o < 64; o <<= 1) { const float t = __shfl_up(cm, o); if (lane >= o) cm = fmaxf(cm, t); }
        const float Mt = fmaxf(m0, cm);
        tg[lane] = g; tM[lane] = Mt; ta[lane] = __expf(m0 - Mt); tb[lane] = bc;
    }
#pragma unroll
    for (int i = 0; i < 2; ++i) { const int ch = F.tid + 512 * i, s = ch >> 4, c16 = ch & 15;
        *(LAS v4u*)(F.lds + MC_QOFF + s * RPQK + 16 * c16) = R.q[i]; *(LAS v4u*)(F.lds + MC_KOFF + s * RPQK + 16 * c16) = R.k[i]; }
#pragma unroll
    for (int i = 0; i < 4; ++i) { const int ch = F.tid + 512 * i, s = ch >> 5, c16 = ch & 31;
        *(LAS v4u*)(F.lds + MC_VOFF + s * RPV + 16 * c16) = R.v[i]; }
    if (next_unit >= 0) p4_mlstm_c_load(F, next_unit, Rn);
    __syncthreads();
    { const int t = F.tid & 63, dq = F.tid >> 6; float a = 0.f;
#pragma unroll
      for (int d = 0; d < 16; ++d) a += nreg[d] * bf1(*(LAS bf16*)(F.lds + MC_QOFF + t * RPQK + (16 * dq + d) * 2));
      tss[dq * 64 + t] = a; }
    __syncthreads();
    if (F.tid < 64) { float a = 0.f;
#pragma unroll
        for (int i = 0; i < 8; ++i) a += tss[i * 64 + F.tid];
        tnq[F.tid] = a; }
    const int tcol = 32 * tt + r;
    const float Mt = tM[tcol], at = ta[tcol];
    bf16x8 Sf[2][2];
    float colsum = 0.f;
#pragma unroll
    for (int st = 0; st < 2; ++st) {
        f32x16 X = zero16();
        if (st <= tt) {
#pragma unroll
            for (int ks = 0; ks < 8; ++ks) X = MFMA32(*(LAS bf16x8*)(F.lds + MC_KOFF + (32 * st + r) * RPQK + (16 * ks + 8 * hh) * 2), *(LAS bf16x8*)(F.lds + MC_QOFF + tcol * RPQK + (16 * ks + 8 * hh) * 2), X);
#pragma unroll
            for (int i = 0; i < 16; ++i) { const int s = 32 * st + (i & 3) + 8 * (i >> 2) + 4 * hh;
                const float dv = (s <= tcol) ? __expf(tg[s] - Mt) : 0.f; X[i] *= dv; colsum += X[i]; }
        }
#pragma unroll
        for (int s2 = 0; s2 < 2; ++s2) { v4u pk; pk.x = cvt2(X[8 * s2], X[8 * s2 + 1]); pk.y = cvt2(X[8 * s2 + 2], X[8 * s2 + 3]); pk.z = cvt2(X[8 * s2 + 4], X[8 * s2 + 5]); pk.w = cvt2(X[8 * s2 + 6], X[8 * s2 + 7]);
            Sf[st][s2] = __builtin_bit_cast(bf16x8, pk); }
    }
    colsum = xhalf_sum(colsum);
    __syncthreads();
    const float den = at * tnq[tcol] + colsum;
    const float mt_abs = tb[tcol] + Mt;
    const float dn = 1.f / fmaxf(fabsf(den), __expf(-mt_abs));
    bf16x8 Qs[8];
#pragma unroll
    for (int ks = 0; ks < 8; ++ks) { const v4u qv = *(LAS v4u*)(F.lds + MC_QOFF + tcol * RPQK + (16 * ks + 8 * hh) * 2);
        v4u o; o.x = cvt2(bflo(qv.x) * at, bfhi(qv.x) * at); o.y = cvt2(bflo(qv.y) * at, bfhi(qv.y) * at); o.z = cvt2(bflo(qv.z) * at, bfhi(qv.z) * at); o.w = cvt2(bflo(qv.w) * at, bfhi(qv.w) * at);
        Qs[ks] = __builtin_bit_cast(bf16x8, o); }
    f32x16 H[2]; float ssq = 0.f;
#pragma unroll
    for (int ks = 0; ks < 8; ++ks) Cf[1][ks] = *(const GAS bf16x8*)(cst + (size_t)(32 * (vg + 4) + r) * 128 + 16 * ks + 8 * hh);
#pragma unroll
    for (int vi = 0; vi < 2; ++vi) {
        const int vt = vg + 4 * vi;
        f32x16 acc = zero16();
#pragma unroll
        for (int ks = 0; ks < 8; ++ks) acc = MFMA32(Cf[vi][ks], Qs[ks], acc);
#pragma unroll
        for (int st = 0; st < 2; ++st) if (st <= tt) {
#pragma unroll
            for (int s2 = 0; s2 < 2; ++s2) {
                const bf16x8 Vf = cat8(tr_read4(F.lds + MC_VOFF, 32 * st + 16 * s2 + 4 * hh, 32 * vt + 16 * blk, RPV, lane), tr_read4(F.lds + MC_VOFF, 32 * st + 16 * s2 + 8 + 4 * hh, 32 * vt + 16 * blk, RPV, lane));
                acc = MFMA32(Vf, Sf[st][s2], acc);
            }
        }
#pragma unroll
        for (int i = 0; i < 16; ++i) { acc[i] *= dn; ssq += acc[i] * acc[i]; }
        H[vi] = acc;
    }
    ssq = xhalf_sum(ssq);
    if (hh == 0) tss[F.wave * 32 + r] = ssq;
    __syncthreads();
    float tot = 0.f;
#pragma unroll
    for (int w2 = 0; w2 < 4; ++w2) tot += tss[(2 * w2 + tt) * 32 + r];
    const float rs = 1.f / sqrtf(tot * (1.f / 256.f) + RMS_EPS);
    const size_t trow = (size_t)(row0 + tcol);
    const bf16* mop = F.P + trow * NPAD + C_MO + h * 256; const bf16* mzp = F.P + trow * NPAD + C_MZ + h * 256; bf16* mp = F.MIX + trow * DM + 1024 + h * 256;
    const float* nw = F.ml_norm_w + h * 256;
#pragma unroll
    for (int vi = 0; vi < 2; ++vi)
#pragma unroll
        for (int g = 0; g < 4; ++g) { const int v = 32 * (vg + 4 * vi) + 8 * g + 4 * hh;
            const v2u mo = *(const GAS v2u*)(mop + v), mz = *(const GAS v2u*)(mzp + v); const f32x4 w4 = *(const GAS f32x4*)(nw + v);
            const float o0 = H[vi][4 * g] * rs * w4.x * sigmoidf_(bflo(mo.x)) * siluf_(bflo(mz.x)), o1 = H[vi][4 * g + 1] * rs * w4.y * sigmoidf_(bfhi(mo.x)) * siluf_(bfhi(mz.x));
            const float o2 = H[vi][4 * g + 2] * rs * w4.z * sigmoidf_(bflo(mo.y)) * siluf_(bflo(mz.y)), o3 = H[vi][4 * g + 3] * rs * w4.w * sigmoidf_(bfhi(mo.y)) * siluf_(bfhi(mz.y));
            v2u o; o.x = cvt2(o0, o1); o.y = cvt2(o2, o3); *(GAS v2u*)(mp + v) = o; }
}

constexpr int MC_HALF = MC_TOFF + 2304;
__device__ __forceinline__ void p4_mlstm_c2(Frame& F, int unitA, int unitB) {
    const int lane = F.lane, r = lane & 31, hh = lane >> 5, blk = (lane >> 4) & 1;
    const int half = F.wave >> 2, hw = F.wave & 3, htid = F.tid & 255;
    const int unit = half ? unitB : unitA; const bool act = unit >= 0;
    const int uu = act ? unit : 0;
    const int c = uu & 63, h = (uu >> 6) & 3, b = uu >> 8, row0 = b * SEQ + 64 * c;
    LAS unsigned char* LB = F.lds + half * MC_HALF;
    LAS float* tg = (LAS float*)(LB + MC_TOFF); LAS float* tM = tg + 64; LAS float* ta = tg + 128; LAS float* tb = tg + 192; LAS float* tnq = tg + 256; LAS float* tss = tg + 320;
    const int tt = hw & 1, vg = hw >> 1, tcol = 32 * tt + r;
    const bf16* cst = F.CST + (size_t)uu * 32768;
    const float m0 = F.MST[uu];
    float ig = 0.f, lf = 0.f;
    if (hw == 0) { ig = F.IG[(size_t)(row0 + lane) * 4 + h]; lf = F.LF[(size_t)(row0 + lane) * 4 + h]; }
    v4u qr[4], kr[4], vr[8];
#pragma unroll
    for (int i = 0; i < 4; ++i) { const int ch = htid + 256 * i, s = ch >> 4, c16 = ch & 15;
        qr[i] = *(const GAS v4u*)(F.P + (size_t)(row0 + s) * NPAD + C_MQ + h * 128 + 8 * c16); kr[i] = *(const GAS v4u*)(F.P + (size_t)(row0 + s) * NPAD + C_MK + h * 128 + 8 * c16); }
#pragma unroll
    for (int i = 0; i < 8; ++i) { const int ch = htid + 256 * i, s = ch >> 5, c16 = ch & 31; vr[i] = *(const GAS v4u*)(F.P + (size_t)(row0 + s) * NPAD + C_MV + h * 256 + 8 * c16); }
    float nreg[32];
    { const GAS f32x4* np4 = (const GAS f32x4*)(F.NST + (size_t)uu * 128 + 32 * (htid >> 6));
#pragma unroll
      for (int i = 0; i < 8; ++i) { const f32x4 t4 = np4[i]; nreg[4 * i] = t4.x; nreg[4 * i + 1] = t4.y; nreg[4 * i + 2] = t4.z; nreg[4 * i + 3] = t4.w; } }
    __syncthreads();
    if (hw == 0) {
        float bc = lf;
#pragma unroll
        for (int o = 1; o < 64; o <<= 1) { const float t = __shfl_up(bc, o); if (lane >= o) bc += t; }
        const float g = ig - bc;
        float cm = g;
#pragma unroll
        for (int o = 1; o < 64; o <<= 1) { const float t = __shfl_up(cm, o); if (lane >= o) cm = fmaxf(cm, t); }
        const float Mt_ = fmaxf(m0, cm);
        tg[lane] = g; tM[lane] = Mt_; ta[lane] = __expf(m0 - Mt_); tb[lane] = bc;
    }
#pragma unroll
    for (int i = 0; i < 4; ++i) { const int ch = htid + 256 * i, s = ch >> 4, c16 = ch & 15;
        *(LAS v4u*)(LB + MC_QOFF + s * RPQK + 16 * c16) = qr[i]; *(LAS v4u*)(LB + MC_KOFF + s * RPQK + 16 * c16) = kr[i]; }
#pragma unroll
    for (int i = 0; i < 8; ++i) { const int ch = htid + 256 * i, s = ch >> 5, c16 = ch & 31; *(LAS v4u*)(LB + MC_VOFF + s * RPV + 16 * c16) = vr[i]; }
    bf16x8 Cf[2][8];
#pragma unroll
    for (int ks = 0; ks < 8; ++ks) Cf[0][ks] = *(const GAS bf16x8*)(cst + (size_t)(32 * vg + r) * 128 + 16 * ks + 8 * hh);
    __syncthreads();
    { const int t = htid & 63, dq = htid >> 6; float a = 0.f;
#pragma unroll
      for (int d = 0; d < 32; ++d) a += nreg[d] * bf1(*(LAS bf16*)(LB + MC_QOFF + t * RPQK + (32 * dq + d) * 2));
      tss[dq * 64 + t] = a; }
    __syncthreads();
    if (htid < 64) tnq[htid] = (tss[htid] + tss[64 + htid]) + (tss[128 + htid] + tss[192 + htid]);
    const float Mt = tM[tcol], at = ta[tcol];
    bf16x8 Sf[2][2];
    float colsum = 0.f;
#pragma unroll
    for (int st = 0; st < 2; ++st) {
        f32x16 X = zero16();
        if (st <= tt) {
#pragma unroll
            for (int ks = 0; ks < 8; ++ks) X = MFMA32(*(LAS bf16x8*)(LB + MC_KOFF + (32 * st + r) * RPQK + (16 * ks + 8 * hh) * 2), *(LAS bf16x8*)(LB + MC_QOFF + tcol * RPQK + (16 * ks + 8 * hh) * 2), X);
#pragma unroll
            for (int i = 0; i < 16; ++i) { const int so = 32 * st + (i & 3) + 8 * (i >> 2);
                const float e = __expf((tg + 4 * hh)[so] - Mt); const float dv = (so + 4 * hh <= tcol) ? e : 0.f; X[i] *= dv; colsum += X[i]; }
        }
#pragma unroll
        for (int s2 = 0; s2 < 2; ++s2) { v4u pk; pk.x = cvt2(X[8 * s2], X[8 * s2 + 1]); pk.y = cvt2(X[8 * s2 + 2], X[8 * s2 + 3]); pk.z = cvt2(X[8 * s2 + 4], X[8 * s2 + 5]); pk.w = cvt2(X[8 * s2 + 6], X[8 * s2 + 7]);
            Sf[st][s2] = __builtin_bit_cast(bf16x8, pk); }
    }
    colsum = xhalf_sum(colsum);
    __syncthreads();
    const float den = at * tnq[tcol] + colsum;
    const float dn = 1.f / fmaxf(fabsf(den), __expf(-(tb[tcol] + Mt)));
    bf16x8 Qs[8];
#pragma unroll
    for (int ks = 0; ks < 8; ++ks) { const v4u qv = *(LAS v4u*)(LB + MC_QOFF + tcol * RPQK + (16 * ks + 8 * hh) * 2);
        v4u o; o.x = cvt2(bflo(qv.x) * at, bfhi(qv.x) * at); o.y = cvt2(bflo(qv.y) * at, bfhi(qv.y) * at); o.z = cvt2(bflo(qv.z) * at, bfhi(qv.z) * at); o.w = cvt2(bflo(qv.w) * at, bfhi(qv.w) * at);
        Qs[ks] = __builtin_bit_cast(bf16x8, o); }
    f32x16 H[4]; float ssq = 0.f;
#pragma unroll
    for (int vi = 0; vi < 4; ++vi) {
        const int vt = vg + 2 * vi;
        if (vi < 3) {
#pragma unroll
            for (int ks = 0; ks < 8; ++ks) Cf[(vi + 1) & 1][ks] = *(const GAS bf16x8*)(cst + (size_t)(32 * (vt + 2) + r) * 128 + 16 * ks + 8 * hh); }
        f32x16 acc = zero16();
#pragma unroll
        for (int ks = 0; ks < 8; ++ks) acc = MFMA32(Cf[vi & 1][ks], Qs[ks], acc);
#pragma unroll
        for (int st = 0; st < 2; ++st) if (st <= tt) {
#pragma unroll
            for (int s2 = 0; s2 < 2; ++s2) {
                const bf16x8 Vf = cat8(tr_read4(LB + MC_VOFF, 32 * st + 16 * s2 + 4 * hh, 32 * vt + 16 * blk, RPV, lane), tr_read4(LB + MC_VOFF, 32 * st + 16 * s2 + 8 + 4 * hh, 32 * vt + 16 * blk, RPV, lane));
                acc = MFMA32(Vf, Sf[st][s2], acc);
            }
        }
#pragma unroll
        for (int i = 0; i < 16; ++i) { acc[i] *= dn; ssq += acc[i] * acc[i]; }
        H[vi] = acc;
    }
    ssq = xhalf_sum(ssq);
    if (hh == 0) tss[hw * 32 + r] = ssq;
    __syncthreads();
    const float rs = 1.f / sqrtf((tss[tt * 32 + r] + tss[(tt + 2) * 32 + r]) * (1.f / 256.f) + RMS_EPS);
#pragma unroll
    for (int vi = 0; vi < 4; ++vi)
#pragma unroll
        for (int g = 0; g < 4; ++g) *(LAS f32x4*)(LB + tcol * 1040 + (32 * (vg + 2 * vi) + 8 * g + 4 * hh) * 4) = (f32x4){H[vi][4 * g] * rs, H[vi][4 * g + 1] * rs, H[vi][4 * g + 2] * rs, H[vi][4 * g + 3] * rs};
    __syncthreads();
    if (act) {
        const int ck = htid & 31;
        const float* nw = F.ml_norm_w + h * 256 + 8 * ck;
        const f32x4 w0 = *(const GAS f32x4*)nw, w1 = *(const GAS f32x4*)(nw + 4);
#pragma unroll 1
        for (int ib = 0; ib < 8; ib += 4) {
        v4u mo[4], mz[4];
#pragma unroll
        for (int i = 0; i < 4; ++i) { const size_t trow = (size_t)(row0 + (htid >> 5) + 8 * (ib + i));
            mo[i] = *(const GAS v4u*)(F.P + trow * NPAD + C_MO + h * 256 + 8 * ck); mz[i] = *(const GAS v4u*)(F.P + trow * NPAD + C_MZ + h * 256 + 8 * ck); }
#pragma unroll
        for (int i = 0; i < 4; ++i) { const int t = (htid >> 5) + 8 * (ib + i);
            const f32x4 h0 = *(LAS f32x4*)(LB + t * 1040 + 32 * ck), h1 = *(LAS f32x4*)(LB + t * 1040 + 32 * ck + 16);
            v4u o;
            o.x = cvt2(h0.x * w0.x * sigmoidf_(bflo(mo[i].x)) * siluf_(bflo(mz[i].x)), h0.y * w0.y * sigmoidf_(bfhi(mo[i].x)) * siluf_(bfhi(mz[i].x)));
            o.y = cvt2(h0.z * w0.z * sigmoidf_(bflo(mo[i].y)) * siluf_(bflo(mz[i].y)), h0.w * w0.w * sigmoidf_(bfhi(mo[i].y)) * siluf_(bfhi(mz[i].y)));
            o.z = cvt2(h1.x * w1.x * sigmoidf_(bflo(mo[i].z)) * siluf_(bflo(mz[i].z)), h1.y * w1.y * sigmoidf_(bfhi(mo[i].z)) * siluf_(bfhi(mz[i].z)));
            o.w = cvt2(h1.z * w1.z * sigmoidf_(bflo(mo[i].w)) * siluf_(bflo(mz[i].w)), h1.w * w1.w * sigmoidf_(bfhi(mo[i].w)) * siluf_(bfhi(mz[i].w)));
            *(GAS v4u*)(F.MIX + (size_t)(row0 + t) * DM + 1024 + h * 256 + 8 * ck) = o; }
        }
    }
}
__device__ __forceinline__ void p4_sample_attn(Frame& F, int s) {
    const int lane = F.lane, w = F.wave, kvh = w >> 2, ck = w & 3;
    LAS float* ql = (LAS float*)F.lds;
    LAS int* il = (LAS int*)(F.lds + 4096);
    LAS float* pl = (LAS float*)(F.lds + 5120);
    LAS float* st = (LAS float*)(F.lds + 13312);
    LAS float* ob = (LAS float*)(F.lds + 14336);
    __syncthreads();
    if (F.tid < 256) { const int idx = F.SIDX[s * 256 + F.tid]; il[F.tid] = (idx < PAST) ? F.page_table[s * NPAGES + (idx >> 7)] * PAGE + (idx & 127) : -1; }
    { const unsigned wq = *(const GAS unsigned*)(F.P + (size_t)(MP + s) * NPAD + C_Q + 2 * F.tid); ql[2 * F.tid] = bflo(wq); ql[2 * F.tid + 1] = bfhi(wq); }
    __syncthreads();
    {
        const int k16 = lane >> 2, p4 = lane & 3;
        float lgk[4][4];
#pragma unroll 1
        for (int ps_ = 0; ps_ < 4; ++ps_) {
            const int ro = il[64 * ck + 16 * ps_ + k16];
            const float* kr = ((ro >= 0) ? F.cache_k + ((size_t)ro * 2 + kvh) * 128 : F.out + O_KS + (size_t)s * 256 + kvh * 128) + 4 * p4;
            f32x4 kv[8];
#pragma unroll
            for (int i = 0; i < 8; ++i) kv[i] = *(const GAS f32x4*)(kr + 16 * i);
            float a[4] = {0.f, 0.f, 0.f, 0.f};
#pragma unroll
            for (int i = 0; i < 8; ++i)
#pragma unroll
                for (int g = 0; g < 4; ++g) { const f32x4 qv = *(LAS f32x4*)(ql + (4 * kvh + g) * 128 + 16 * i + 4 * p4); a[g] += kv[i].x * qv.x + kv[i].y * qv.y + kv[i].z * qv.z + kv[i].w * qv.w; }
#pragma unroll
            for (int g = 0; g < 4; ++g) { float t = a[g]; t += __shfl_xor(t, 1); t += __shfl_xor(t, 2); if (ps_ == 0) lgk[0][g] = t; else if (ps_ == 1) lgk[1][g] = t; else if (ps_ == 2) lgk[2][g] = t; else lgk[3][g] = t; }
        }
#pragma unroll
        for (int g = 0; g < 4; ++g) {
            float mx = -INFINITY;
#pragma unroll
            for (int ps_ = 0; ps_ < 4; ++ps_) { lgk[ps_][g] *= ATT_C; mx = fmaxf(mx, lgk[ps_][g]); }
            mx = wave_max(mx);
            float sm = 0.f;
#pragma unroll
            for (int ps_ = 0; ps_ < 4; ++ps_) { const float pv = __builtin_amdgcn_exp2f(lgk[ps_][g] - mx); sm += pv; if (p4 == 0) pl[(4 * kvh + g) * 256 + 64 * ck + 16 * ps_ + k16] = pv; }
            sm = wave_sum(sm) * 0.25f;
            if (lane == 0) { st[(w * 4 + g) * 2] = mx; st[(w * 4 + g) * 2 + 1] = sm; }
        }
    }
    LDS_WAIT(); asm volatile("" ::: "memory");
    {
        float o[4][2] = {{0.f, 0.f}, {0.f, 0.f}, {0.f, 0.f}, {0.f, 0.f}};
#pragma unroll 1
        for (int jb = 0; jb < 64; jb += 16) {
            f32x2 vv[16];
#pragma unroll
            for (int k = 0; k < 16; ++k) { const int ro = il[64 * ck + jb + k];
                const float* vr = (ro >= 0) ? F.cache_v + ((size_t)ro * 2 + kvh) * 128 : F.out + O_VS + (size_t)s * 256 + kvh * 128;
                vv[k] = *(const GAS f32x2*)(vr + 2 * lane); }
#pragma unroll
            for (int k = 0; k < 16; ++k)
#pragma unroll
                for (int g = 0; g < 4; ++g) { const float p = pl[(4 * kvh + g) * 256 + 64 * ck + jb + k]; o[g][0] += p * vv[k].x; o[g][1] += p * vv[k].y; }
        }
#pragma unroll
        for (int g = 0; g < 4; ++g) *(LAS f32x2*)(ob + (w * 4 + g) * 128 + 2 * lane) = (f32x2){o[g][0], o[g][1]};
    }
    __syncthreads();
    {
        const int hq = F.tid >> 6, kv2 = hq >> 2, g = hq & 3, d = 2 * (F.tid & 63);
        float M = -INFINITY;
#pragma unroll
        for (int c = 0; c < 4; ++c) M = fmaxf(M, st[((4 * kv2 + c) * 4 + g) * 2]);
        float L = 0.f, o0 = 0.f, o1 = 0.f;
#pragma unroll
        for (int c = 0; c < 4; ++c) { const int ww = 4 * kv2 + c; const float sc = __builtin_amdgcn_exp2f(st[(ww * 4 + g) * 2] - M); L += st[(ww * 4 + g) * 2 + 1] * sc;
            const f32x2 ov = *(LAS f32x2*)(ob + (ww * 4 + g) * 128 + d); o0 += ov.x * sc; o1 += ov.y * sc; }
        const float inv = 1.f / L;
        const unsigned az = *(const GAS unsigned*)(F.P + (size_t)(MP + s) * NPAD + C_AZ + hq * 128 + d);
        *(GAS unsigned*)(F.MIX + (size_t)(MP + s) * DM + hq * 128 + d) = cvt2(o0 * inv * siluf_(bflo(az)), o1 * inv * siluf_(bfhi(az)));
    }
}
__device__ __forceinline__ void p4_sample_mlstm(Frame& F, int s, int h) {
    const int lane = F.lane, tid = F.tid;
    LAS float* ql = (LAS float*)F.lds; LAS float* kl = ql + 128; LAS float* vl = ql + 256; LAS float* hl = ql + 512; LAS float* red = ql + 768;
    const size_t row = (size_t)(MP + s);
    __syncthreads();
    if (tid < 128) { ql[tid] = bf1(F.P[row * NPAD + C_MQ + h * 128 + tid]); kl[tid] = bf1(F.P[row * NPAD + C_MK + h * 128 + tid]); }
    if (tid < 256) vl[tid] = bf1(F.P[row * NPAD + C_MV + h * 256 + tid]);
    __syncthreads();
    const float ig = F.IG[row * 4 + h], lf = F.LF[row * 4 + h], m = F.state_m[s * 4 + h];
    const float mt = fmaxf(lf + m, ig), dd = __expf(ig - mt), a = __expf(lf + m - mt);
    const float* np = F.state_n + (size_t)(s * 4 + h) * 128;
    const float qk = wave_sum(ql[lane] * kl[lane] + ql[lane + 64] * kl[lane + 64]);
    const float nq = wave_sum(np[lane] * ql[lane] + np[lane + 64] * ql[lane + 64]);
    const float sv = qk * dd, den = a * nq + sv, dn = 1.f / fmaxf(fabsf(den), __expf(-mt));
    const int hw = tid >> 5, l32 = tid & 31;
    const float* Cp = F.state_C + (size_t)(s * 4 + h) * 32768; float* Co = F.out + O_CS + (size_t)(s * 4 + h) * 32768;
    const f32x4 q4 = *(LAS f32x4*)(ql + 4 * l32), k4 = *(LAS f32x4*)(kl + 4 * l32);
    f32x4 cr[16];
#pragma unroll
    for (int it = 0; it < 16; ++it) cr[it] = __builtin_nontemporal_load((const GAS f32x4*)(Cp + (size_t)(hw + 16 * it) * 128 + 4 * l32));
#pragma unroll
    for (int it = 0; it < 16; ++it) {
        const int v = hw + 16 * it;
        const f32x4 c4 = cr[it];
        float dot = c4.x * q4.x + c4.y * q4.y + c4.z * q4.z + c4.w * q4.w;
#pragma unroll
        for (int o = 1; o < 32; o <<= 1) dot += __shfl_xor(dot, o);
        const float vv = vl[v], dv = dd * vv;
        *(GAS f32x4*)(Co + (size_t)v * 128 + 4 * l32) = (f32x4){a * c4.x + dv * k4.x, a * c4.y + dv * k4.y, a * c4.z + dv * k4.z, a * c4.w + dv * k4.w};
        if (l32 == 0) hl[v] = (a * dot + sv * vv) * dn;
    }
    if (tid < 128) F.out[O_NS + (size_t)(s * 4 + h) * 128 + tid] = a * np[tid] + dd * kl[tid];
    if (tid == 0) F.out[O_MSS + s * 4 + h] = mt;
    __syncthreads();
    float hv = (tid < 256) ? hl[tid] : 0.f;
    const float w2 = wave_sum(hv * hv);
    if (lane == 0) red[F.wave] = w2;
    __syncthreads();
    float tot = 0.f;
#pragma unroll
    for (int i = 0; i < NWAVES; ++i) tot += red[i];
    const float rs = 1.f / sqrtf(tot * (1.f / 256.f) + RMS_EPS);
    if (tid < 256) {
        const float mo = bf1(F.P[row * NPAD + C_MO + h * 256 + tid]), mz = bf1(F.P[row * NPAD + C_MZ + h * 256 + tid]);
        F.MIX[row * DM + 1024 + h * 256 + tid] = (bf16)f2bf(hv * rs * F.ml_norm_w[h * 256 + tid] * sigmoidf_(mo) * siluf_(mz));
    }
}
__device__ __forceinline__ void p4_phase(Frame& F) {
    const int j = blockIdx.x;
    if (F.G == 256) {
        REPEAT(41) { REP_BAR(); if (j >= 224) p4_sample_attn(F, 255 - j); else if (j >= 96) p4_sample_mlstm(F, (223 - j) >> 2, (223 - j) & 3); REP_BAR(); }
        const bool mfirst = ((j >> 3) & 1) && DUP_SUB == 0;
        if (mfirst) { __syncthreads(); p4_mlstm_c2(F, j, j + 256); __syncthreads(); }
        for (int uu_ = 0, nu_ = (DUP_SUB == 42) ? 2 * F.two : 2; uu_ < nu_; ++uu_) { if (DUP_SUB == 42 && (uu_ & 1) == 0) xcd_barrier(*F.bar); p4_attn_unit(F, (j & 3) * 128 + ((uu_ & 1) ? (j >> 2) : 127 - (j >> 2))); }
        if (DUP_SUB == 42) xcd_barrier(*F.bar);
        if (!mfirst) {
        REPEAT(43) { REP_BAR(); p4_mlstm_c2(F, j, j + 256); REP_BAR(); }
        }
    } else {
        for (int s = j; s < MS; s += F.G) p4_sample_attn(F, s);
        for (int t = j; t < MS * 4; t += F.G) p4_sample_mlstm(F, t >> 2, t & 3);
        for (int u = j; u < 512; u += F.G) p4_attn_unit(F, u);
        for (int u = j; u < 512; u += 2 * F.G) p4_mlstm_c2(F, u, (u + F.G < 512) ? u + F.G : -1);
    }
}

struct EpiOut {
    static constexpr bool PERM = false, AFTER_DRAIN = false;
    const float* x; float* y;
    __device__ __forceinline__ void operator()(const pg8::f32x4 (&acc)[2][2][4][2], const pg8::Unit& u, int wr, int wc, int fr, int fq) const {
        const int row0 = u.pm * 256 + wr * 64 + fr, col0 = u.pn * 256 + wc * 32 + 4 * fq;
#pragma unroll
        for (int ai = 0; ai < 2; ++ai)
#pragma unroll
            for (int m = 0; m < 4; ++m) { const size_t o = (size_t)(row0 + ai * 128 + m * 16) * DM + col0;
#pragma unroll
                for (int bj = 0; bj < 2; ++bj)
#pragma unroll
                    for (int n = 0; n < 2; ++n) *(f32x4*)(y + o + bj * 128 + n * 16) = acc[ai][bj][m][n] + *(const f32x4*)(x + o + bj * 128 + n * 16); }
    }
};
__device__ __forceinline__ void p5_sample_out(Frame& F, int j) {
    const int lane = F.lane, r = lane & 31, hh = lane >> 5, w = F.wave;
    f32x16 acc = zero16();
    const bf16* ap = F.MIX + (size_t)(MP + r) * DM + 256 * w + 8 * hh; const bf16* bp = F.WOUTT + (size_t)(32 * j + r) * DM + 256 * w + 8 * hh;
#pragma unroll
    for (int ks = 0; ks < 16; ++ks) acc = MFMA32(*(const GAS bf16x8*)(ap + 16 * ks), *(const GAS bf16x8*)(bp + 16 * ks), acc);
    LAS float* pl = (LAS float*)F.lds;
    __syncthreads();
#pragma unroll
    for (int i = 0; i < 16; ++i) pl[(w * 32 + (i & 3) + 8 * (i >> 2) + 4 * hh) * 33 + r] = acc[i];
    __syncthreads();
    const int row = F.tid >> 4, c2 = (F.tid & 15) * 2;
    float s0 = 0.f, s1 = 0.f;
#pragma unroll
    for (int ww = 0; ww < NWAVES; ++ww) { s0 += pl[(ww * 32 + row) * 33 + c2]; s1 += pl[(ww * 32 + row) * 33 + c2 + 1]; }
    const f32x2 xs = *(const GAS f32x2*)(F.x_sample + (size_t)row * DM + 32 * j + c2);
    *(GAS f32x2*)(F.out + O_YS + (size_t)row * DM + 32 * j + c2) = (f32x2){s0 + xs.x, s1 + xs.y};
    __syncthreads();
}
struct EpiOutF {
    static constexpr bool PERM = false, AFTER_DRAIN = true;
    const float* x; float* y; const float* fw; float* xch; unsigned* cnt;
    __device__ __forceinline__ void fused(pg8::f32x4 (&acc)[2][2][4][2], const pg8::Unit& u, int wr, int wc, int fr, int fq, PG8_LAS unsigned char* lds, int wid, int lane) const {
        const int col0 = u.pn * 256 + wc * 32 + 4 * fq, tid = wid * 64 + lane;
        LAS float* T = (LAS float*)lds; LAS float* R = (LAS float*)(lds + 4096);
#pragma unroll
        for (int ai = 0; ai < 2; ++ai) {
            f32x4 xv[4][2][2];
#pragma unroll
            for (int m = 0; m < 4; ++m) { const size_t off = (size_t)(u.pm * 256 + ai * 128 + wr * 64 + m * 16 + fr) * DM + col0;
#pragma unroll
                for (int bj = 0; bj < 2; ++bj)
#pragma unroll
                    for (int n = 0; n < 2; ++n) xv[m][bj][n] = __builtin_nontemporal_load((const f32x4*)(x + off + bj * 128 + n * 16)); }
#pragma unroll
            for (int m = 0; m < 4; ++m) { const int row = ai * 128 + wr * 64 + m * 16 + fr;
                float s = 0.f;
#pragma unroll
                for (int bj = 0; bj < 2; ++bj)
#pragma unroll
                    for (int n = 0; n < 2; ++n) { const f32x4 v = acc[ai][bj][m][n] + xv[m][bj][n]; acc[ai][bj][m][n] = v; s += (v[0] * v[0] + v[1] * v[1]) + (v[2] * v[2] + v[3] * v[3]); }
                s += __shfl_xor(s, 16); s += __shfl_xor(s, 32);
                if (fq == 0) T[row * 4 + wc] = s; }
        }
        __syncthreads();
        float* slot = xch + (size_t)(u.pm * 8) * 256 + tid;
        if (tid < 256) { const f32x4 t4 = *(LAS f32x4*)(T + tid * 4); __hip_atomic_store(slot + u.pn * 256, (t4[0] + t4[1]) + (t4[2] + t4[3]), __ATOMIC_RELAXED, __HIP_MEMORY_SCOPE_AGENT); }
        asm volatile("s_waitcnt vmcnt(0)" ::: "memory");
        __syncthreads();
        if (tid == 0) {
            unsigned* c = cnt + 64 * u.pm;
            __hip_atomic_fetch_add(c, 1u, __ATOMIC_RELAXED, __HIP_MEMORY_SCOPE_AGENT);
            unsigned sp = 0;
            while (__hip_atomic_load(c, __ATOMIC_RELAXED, __HIP_MEMORY_SCOPE_AGENT) < 8u) { __builtin_amdgcn_s_sleep(1); if (++sp > (1u << 18)) break; }
        }
        __syncthreads();
        if (tid < 256) { float tot = 0.f;
#pragma unroll
            for (int pn = 0; pn < 8; ++pn) tot += __hip_atomic_load(slot + pn * 256, __ATOMIC_RELAXED, __HIP_MEMORY_SCOPE_AGENT);
            R[tid] = 1.f / sqrtf(tot * (1.f / DM) + RMS_EPS); }
        __syncthreads();
        f32x4 fwv[2][2];
#pragma unroll
        for (int bj = 0; bj < 2; ++bj)
#pragma unroll
            for (int n = 0; n < 2; ++n) fwv[bj][n] = *(const f32x4*)(fw + col0 + bj * 128 + n * 16);
#pragma unroll
        for (int ai = 0; ai < 2; ++ai)
#pragma unroll
            for (int m = 0; m < 4; ++m) { const int row = ai * 128 + wr * 64 + m * 16 + fr; const size_t off = (size_t)(u.pm * 256 + row) * DM + col0; const float rs = R[row];
#pragma unroll
                for (int bj = 0; bj < 2; ++bj)
#pragma unroll
                    for (int n = 0; n < 2; ++n) *(f32x4*)(y + off + bj * 128 + n * 16) = acc[ai][bj][m][n] * rs * fwv[bj][n]; }
    }
};
__device__ __forceinline__ void final_norm_row(float* rowp, const float* fw, int lane) {
    GAS f32x4* xr = (GAS f32x4*)rowp + lane; const GAS f32x4* wr = (const GAS f32x4*)fw + lane;
    f32x4 v[8], wv[8]; float s = 0.f;
#pragma unroll
    for (int i = 0; i < 8; ++i) { v[i] = xr[64 * i]; wv[i] = wr[64 * i]; }
#pragma unroll
    for (int i = 0; i < 8; ++i) s += (v[i].x * v[i].x + v[i].y * v[i].y) + (v[i].z * v[i].z + v[i].w * v[i].w);
    const float rstd = 1.f / sqrtf(wave_sum(s) * (1.f / DM) + RMS_EPS);
#pragma unroll
    for (int i = 0; i < 8; ++i) { const f32x4 ww = wv[i]; xr[64 * i] = (f32x4){v[i].x * rstd * ww.x, v[i].y * rstd * ww.y, v[i].z * rstd * ww.z, v[i].w * rstd * ww.w}; }
}
__device__ __forceinline__ void p5_phase(Frame& F) {
    pg8::Gemm g{F.MIX, F.WOUTT, MP, DM, DM}; pg8::StaticOrder S; S.init(MP, DM, F.G, (int)blockIdx.x);
    if (F.G == 256) {
        EpiOutF E{F.x_prompt, F.out + O_Y, F.final_norm_w, F.XCH, F.ctl + CW_PCNT};
        pg8::gemm_phase<EpiOutF, pg8::StaticOrder, false, true>(F.lds, g, S, E);
        __syncthreads();
    } else {
        EpiOut E{F.x_prompt, F.out + O_Y};
        pg8::gemm_phase<EpiOut, pg8::StaticOrder, true, true>(F.lds, g, S, E);
    }
    for (int j = blockIdx.x; j < 64; j += F.G) {
        p5_sample_out(F, j);
        if (F.G == 256) {
            LAS unsigned* flag = (LAS unsigned*)(F.lds + 40960);
            VM_WAIT(); __syncthreads();
            if (F.tid == 0) {
                __builtin_amdgcn_fence(__ATOMIC_RELEASE, "agent"); VM_WAIT();
                const unsigned old = __hip_atomic_fetch_add(F.ctl + CW_SCNT, 1u, __ATOMIC_RELAXED, __HIP_MEMORY_SCOPE_AGENT);
                if (old == 63u) { __builtin_amdgcn_fence(__ATOMIC_ACQUIRE, "agent"); VM_WAIT(); }
                *flag = (old == 63u) ? 1u : 0u;
            }
            __syncthreads();
            if (*flag) for (int rr = F.wave; rr < MS; rr += NWAVES) final_norm_row(F.out + O_YS + (size_t)rr * DM, F.final_norm_w, F.lane);
            __syncthreads();
        }
    }
}
__device__ __forceinline__ void p6_phase(Frame& F) {
    const int gw = blockIdx.x * NWAVES + F.wave, NGW = F.G * NWAVES;
    for (int m = gw; m < MROWS; m += NGW) final_norm_row((m < MP) ? F.out + O_Y + (size_t)m * DM : F.out + O_YS + (size_t)(m - MP) * DM, F.final_norm_w, F.lane);
}
__device__ __forceinline__ void p1_phase(Frame& F) {
    pg8::Gemm g{F.XN, F.WINT, MPAD, NPAD, DM}; pg8::StaticOrder S; S.init(MPAD, NPAD, F.G, (int)blockIdx.x);
    EpiIn E{F.P, F.out, F.WI, F.IG, F.LF, F.KIB, F.b_i, F.b_f, F.KVC};
    pg8::gemm_phase<EpiIn, pg8::StaticOrder, true, true>(F.lds, g, S, E);
}
#ifndef MK_N_LAUNCHES
#define MK_N_LAUNCHES 1
#endif
constexpr int N_PHASES = 7;
struct Args { const void* in[16]; float* out; unsigned char* ws; int ph_lo, ph_hi, two, pad; };
__global__ void __launch_bounds__(NTHR, 2) mk_fwd(Args args) {
    extern __shared__ __attribute__((aligned(16))) unsigned char lds[];
    Frame F;
    F.lds = (LAS unsigned char*)lds;
    F.tid = threadIdx.x; F.lane = F.tid & 63; F.wave = __builtin_amdgcn_readfirstlane(F.tid >> 6);
    F.G = gridDim.x; { const int bx = blockIdx.x; F.vcu = (F.G % 8 == 0) ? (bx % 8) * (F.G / 8) + bx / 8 : bx; }
    unsigned char* ws = args.ws;
    F.x_prompt = (const float*)args.in[0]; F.x_sample = (const float*)args.in[1]; F.cache_k = (const float*)args.in[2]; F.cache_v = (const float*)args.in[3];
    F.cache_ik = (const float*)args.in[4]; F.state_C = (const float*)args.in[5]; F.state_n = (const float*)args.in[6]; F.state_m = (const float*)args.in[7];
    F.page_table = (const int*)args.in[8]; F.norm_w = (const float*)args.in[9]; F.w_in = (const float*)args.in[10]; F.b_i = (const float*)args.in[11];
    F.b_f = (const float*)args.in[12]; F.ml_norm_w = (const float*)args.in[13]; F.w_out = (const float*)args.in[14]; F.final_norm_w = (const float*)args.in[15];
    F.out = args.out; F.two = args.two;
    F.WINT = (bf16*)(ws + WS_WINT); F.WOUTT = (bf16*)(ws + WS_WOUTT); F.XN = (bf16*)(ws + WS_XN); F.P = (bf16*)(ws + WS_P); F.KIB = (bf16*)(ws + WS_KIB);
    F.MIX = (bf16*)(ws + WS_MIX); F.CST = (bf16*)(ws + WS_CST);
    F.WI = (float*)(ws + WS_WI); F.IG = (float*)(ws + WS_IG); F.LF = (float*)(ws + WS_LF); F.UN = (float*)(ws + WS_UN); F.CHG = (float*)(ws + WS_CHG);
    F.NST = (float*)(ws + WS_NST); F.MST = (float*)(ws + WS_MST); F.SS = (float*)(ws + WS_SS); F.SC = (float*)(ws + WS_SC2); F.UP = (float*)(ws + WS_UP);
    F.BMT = (unsigned*)(ws + WS_BMT2); F.SIDX = (int*)(ws + WS_SIDX); F.XCH = (float*)(ws + WS_XCH); F.KVC = (bf16*)(ws + WS_KVC); F.ctl = (unsigned*)(ws + WS_CTL);
    volatile LAS unsigned* MISC = (volatile LAS unsigned*)(F.lds + MISC_OFF);
    for (int u = F.tid; u < (LDS_BYTES - MISC_OFF) / 4; u += NTHR) MISC[u] = 0u;
    __syncthreads();
    const int lo = args.ph_lo, hi = args.ph_hi;
    XcdBarrier bar; bar.bar = (unsigned*)(ws + WS_CTL) + CW_BAR; bar.x = 0; bar.st = nullptr;
    if (hi - lo > 1) bar = xcd_barrier_post((unsigned*)(ws + WS_CTL) + CW_BAR, MISC + 8);
#ifndef ONLY_PH
#define ONLY_PH -1
#endif
    F.bar = &bar;
#define IN(k) ((ONLY_PH < 0 || ONLY_PH == (k)) && lo <= (k) && (k) < hi)
#define SEAM(k) do { if (IN(k) && IN((k) + 1)) xcd_barrier(bar); } while (0)

#ifndef DUP_PH
#define DUP_PH -1
#endif
#define RUN_PHASE(k, call) do { if (IN(k)) { call; if (DUP_PH == (k)) { xcd_barrier(bar); call; } } } while (0)
    RUN_PHASE(0, p0_prologue(F));
    SEAM(0);
    RUN_PHASE(1, p1_phase(F));
    SEAM(1);
    RUN_PHASE(2, p2_phase(F));
    SEAM(2);
    RUN_PHASE(3, p3_phase(F));
    SEAM(3);
#ifndef XBAR_N
#define XBAR_N 0
#endif
    for (int xb_ = 0; xb_ < XBAR_N * (F.two / 2); ++xb_) xcd_barrier(bar);
    RUN_PHASE(4, p4_phase(F));
    SEAM(4);
    RUN_PHASE(5, p5_phase(F));
    if (F.G != 256) { SEAM(5); RUN_PHASE(6, p6_phase(F)); }
}

extern "C" void kernel_launch(void* const* d_in, const int* in_sizes, int n_in, void* d_out, int out_size, void* d_ws, size_t ws_size, hipStream_t stream) {
    static int grid = 0;
    if (grid == 0) {
        if (n_in != 16 || (size_t)out_size != O_END || ws_size < WS_END) { fprintf(stderr, "kernel_launch: unexpected shapes (n_in %d out %d ws %zu)\n", n_in, out_size, ws_size); grid = -1; return; }
        int dev = 0, cus = 0, per_cu = 0;
        if (hipGetDevice(&dev) != hipSuccess || hipDeviceGetAttribute(&cus, hipDeviceAttributeMultiprocessorCount, dev) != hipSuccess) { grid = -1; return; }
        if (hipFuncSetAttribute((const void*)mk_fwd, hipFuncAttributeMaxDynamicSharedMemorySize, LDS_BYTES) != hipSuccess) { fprintf(stderr, "kernel_launch: hipFuncSetAttribute failed\n"); grid = -1; return; }
        if (hipOccupancyMaxActiveBlocksPerMultiprocessor(&per_cu, (const void*)mk_fwd, NTHR, LDS_BYTES) != hipSuccess || per_cu < 1) { fprintf(stderr, "kernel_launch: occupancy query says %d\n", per_cu); }
        (void)hipGetLastError();
        grid = cus;
    }
    if (grid < 0) return;
    if (hipMemsetAsync((char*)d_ws + WS_CTL, 0, CTL_ZERO_BYTES, stream) != hipSuccess) return;
    Args a{};
    for (int i = 0; i < 16; ++i) a.in[i] = d_in[i];
    a.out = (float*)d_out; a.ws = (unsigned char*)d_ws; a.two = 2; a.pad = 0;
    if (MK_N_LAUNCHES == 1) { a.ph_lo = 0; a.ph_hi = N_PHASES; hipLaunchKernelGGL(mk_fwd, dim3(grid), dim3(NTHR), LDS_BYTES, stream, a); }
    else for (int p = 0; p < N_PHASES; ++p) { a.ph_lo = p; a.ph_hi = p + 1; hipLaunchKernelGGL(mk_fwd, dim3(grid), dim3(NTHR), LDS_BYTES, stream, a); }
}
```

```cpp
#include <hip/hip_runtime.h>
#include <cstdio>
#include <cstdint>
namespace pg8 {
#define PG8_LAS __attribute__((address_space(3)))
typedef unsigned short bf16_t;
typedef short bf16x8 __attribute__((ext_vector_type(8)));
typedef float f32x4 __attribute__((ext_vector_type(4)));
typedef unsigned u32x4 __attribute__((ext_vector_type(4)));
constexpr int BM = 256, BK = 64, HALF = 128, HTB = HALF * BK * 2  , STAGE_BYTES = 8 * HTB, NXCD = 8, WGM = 8;

__host__ __device__ __forceinline__ int lds_byte(int r, int c) { const int st = (r >> 4) * 2 + (c >> 5), rr = r & 15, cc = c & 31, ob = rr * 64 + cc * 2; return st * 1024 + (ob ^ (((ob >> 9) & 1) << 5)); }
__host__ __device__ __forceinline__ void stage_rc(int b, int& R, int& C) { const int st = b / 1024, sb = b % 1024, swz = sb ^ (((sb >> 9) & 1) << 5); R = (st >> 1) * 16 + swz / 64; C = (st & 1) * 32 + (swz % 64) / 2; }
__host__ __device__ __forceinline__ int perm32(int rho) { const int n = rho >> 4, i = rho & 15; return 8 * (i >> 2) + 4 * n + (i & 3); }

struct Unit { int pm, pn; };
struct Gemm { const bf16_t* A; const bf16_t* Bt; int M, N, K; };

struct StaticOrder {
    int nM, nN, nwg, G, c;
    __host__ __device__ void init(int M, int N, int G_, int c_) { nM = M / BM; nN = N / BM; nwg = nM * nN; G = G_; c = c_; }
    __host__ __device__ bool next(int i, Unit& u) const {
        const long L = (long)i * G + c; if (L >= nwg) return false;
        int wgid = (int)L; { const int q = nwg / NXCD, r = nwg % NXCD, xcd = wgid % NXCD, off = wgid / NXCD; wgid = (xcd < r ? xcd * (q + 1) : r * (q + 1) + (xcd - r) * q) + off; }
        const int nig = WGM * nN, gid = wgid / nig, fm = gid * WGM, gsz = (nM - fm) < WGM ? (nM - fm) : WGM;
        u.pm = fm + ((wgid % nig) % gsz); u.pn = (wgid % nig) / gsz; return true;
    }
    __device__ __forceinline__ void a_ready(const Unit&) const {}
    __device__ __forceinline__ void done(const Unit&) const {}
};

__device__ __forceinline__ unsigned cvt_pk_bf16(float lo, float hi) { unsigned r; asm volatile("v_cvt_pk_bf16_f32 %0, %1, %2" : "=v"(r) : "v"(lo), "v"(hi)); return r; }
template <class Epi, class Sched, bool ALIGN_EPI = false, bool SP2 = false>
__device__ __forceinline__ void gemm_phase(PG8_LAS unsigned char* lds, const Gemm g, const Sched& S, const Epi& E) {
    const int tid = threadIdx.x, wid = __builtin_amdgcn_readfirstlane(tid >> 6), lane = tid & 63, wr = wid >> 2, wc = wid & 3, fr = lane & 15, fq = lane >> 4;
    const int K = g.K, nt = K / BK;
    unsigned voffA[2], voffB[2];
#pragma unroll
    for (int i = 0; i < 2; ++i) { int R, C; stage_rc(tid * 16 + i * 8192, R, C); const int Rb = Epi::PERM ? ((R & ~31) + perm32(R & 31)) : R;
        voffA[i] = (unsigned)(R * K + C) * 2u; voffB[i] = (unsigned)(Rb * K + C) * 2u; }
    const size_t kstep = (size_t)(BK * 2);
    const size_t hstep = (size_t)HALF * K * 2;
    const size_t tstep = 2 * hstep;
    const unsigned ldsw = (unsigned)wid * 1024u;
    const int aoff = lds_byte(wr * 64 + fr, fq * 8), boff = lds_byte(wc * 32 + fr, fq * 8);
#define PG8_SA(b, h) (((b) * 2 + (h)) * HTB)
#define PG8_SB(b, h) ((4 + (b) * 2 + (h)) * HTB)
#define PG8_STAGE(bufoff, gbase, voff) do { _Pragma("unroll") for (int _i = 0; _i < 2; ++_i) \
        __builtin_amdgcn_global_load_lds((const unsigned*)((const char*)(gbase) + (voff)[_i]), (PG8_LAS unsigned*)(lds + (bufoff) + ldsw + _i * 8192), 16, 0, 0); } while (0)
#define PG8_LDA(dst, b, h) do { _Pragma("unroll") for (int m = 0; m < 4; ++m) _Pragma("unroll") for (int k = 0; k < 2; ++k) dst[m][k] = *(const PG8_LAS bf16x8*)(lds + PG8_SA(b, h) + aoff + m * 2048 + k * 1024); } while (0)
#define PG8_LDB(dst, b, h) do { _Pragma("unroll") for (int n = 0; n < 2; ++n) _Pragma("unroll") for (int k = 0; k < 2; ++k) dst[n][k] = *(const PG8_LAS bf16x8*)(lds + PG8_SB(b, h) + boff + n * 2048 + k * 1024); } while (0)
#define PG8_MMA(ai, bj, At, Bt) do { __builtin_amdgcn_s_setprio(1); _Pragma("unroll") for (int m = 0; m < 4; ++m) _Pragma("unroll") for (int n = 0; n < 2; ++n) _Pragma("unroll") for (int k = 0; k < 2; ++k) \
        acc[ai][bj][m][n] = __builtin_amdgcn_mfma_f32_16x16x32_bf16(Bt[n][k], At[m][k], acc[ai][bj][m][n], 0, 0, 0); __builtin_amdgcn_s_setprio(0); } while (0)
#define PG8_WAIT_V(n) asm volatile("s_waitcnt vmcnt(" #n ")" ::: "memory")
#define PG8_WAIT_L(n) asm volatile("s_waitcnt lgkmcnt(" #n ")" ::: "memory")
#define PG8_BAR __builtin_amdgcn_s_barrier()
#define PG8_SCHED __builtin_amdgcn_sched_barrier(0)
    Unit cur, nxt; int ui = 0;
    if (!S.next(0, cur)) return;
    f32x4 acc[2][2][4][2];
#pragma unroll
    for (int a = 0; a < 2; ++a)
#pragma unroll
        for (int b = 0; b < 2; ++b)
#pragma unroll
            for (int m = 0; m < 4; ++m)
#pragma unroll
                for (int n = 0; n < 2; ++n) acc[a][b][m][n] = (f32x4){0.f, 0.f, 0.f, 0.f};
    bf16x8 At[4][2], B0[2][2], B1[2][2];
    const char* cA = (const char*)g.A + (size_t)cur.pm * tstep; const char* cB = (const char*)g.Bt + (size_t)cur.pn * tstep;
    S.a_ready(cur);
    if constexpr (SP2) {
        PG8_STAGE(PG8_SB(0, 0), cB, voffB); PG8_STAGE(PG8_SB(0, 1), cB + hstep, voffB); PG8_STAGE(PG8_SA(0, 0), cA, voffA); PG8_STAGE(PG8_SA(0, 1), cA + hstep, voffA);
        if (wr == 1) PG8_BAR;
        PG8_WAIT_V(2); PG8_BAR;
        PG8_STAGE(PG8_SB(1, 0), cB + kstep, voffB); PG8_STAGE(PG8_SA(1, 0), cA + kstep, voffA); PG8_STAGE(PG8_SB(1, 1), cB + hstep + kstep, voffB);
        PG8_WAIT_V(6); PG8_BAR;
    } else {
        PG8_STAGE(PG8_SB(0, 0), cB, voffB); PG8_STAGE(PG8_SA(0, 0), cA, voffA); PG8_STAGE(PG8_SB(0, 1), cB + hstep, voffB); PG8_STAGE(PG8_SA(0, 1), cA + hstep, voffA);
        if (wr == 1) PG8_BAR;
        PG8_WAIT_V(4); PG8_BAR;
        PG8_STAGE(PG8_SB(1, 0), cB + kstep, voffB); PG8_STAGE(PG8_SA(1, 0), cA + kstep, voffA); PG8_STAGE(PG8_SB(1, 1), cB + hstep + kstep, voffB);
        PG8_WAIT_V(6); PG8_BAR;
    }
    for (;;) {
        const bool has_next = S.next(ui + 1, nxt);
        const char* nA = has_next ? (const char*)g.A + (size_t)nxt.pm * tstep : cA; const char* nB = has_next ? (const char*)g.Bt + (size_t)nxt.pn * tstep : cB;
        for (int t = 0; t < nt; t += 2) {
            const bool last = (t == nt - 2);
            const char* a1 = cA + (size_t)(t + 1) * kstep;
            const char* a2 = last ? nA : cA + (size_t)(t + 2) * kstep; const char* b2 = last ? nB : cB + (size_t)(t + 2) * kstep;
            const char* a3 = a2 + kstep; const char* b3 = b2 + kstep;
            if (last && has_next) S.a_ready(nxt);
            if constexpr (SP2) {
            PG8_LDB(B0, 0, 0); PG8_LDB(B1, 0, 1); PG8_SCHED; PG8_LDA(At, 0, 0); PG8_STAGE(PG8_SA(1, 1), a1 + hstep, voffA);
            PG8_WAIT_V(8); PG8_WAIT_L(0); PG8_BAR; PG8_MMA(0, 0, At, B0); PG8_MMA(0, 1, At, B1); PG8_BAR; PG8_SCHED;
            PG8_LDA(At, 0, 1); PG8_STAGE(PG8_SB(0, 0), b2, voffB); PG8_STAGE(PG8_SB(0, 1), b2 + hstep, voffB); PG8_STAGE(PG8_SA(0, 0), a2, voffA);
            PG8_WAIT_V(8); PG8_WAIT_L(0); PG8_BAR; PG8_MMA(1, 0, At, B0); PG8_MMA(1, 1, At, B1); PG8_BAR; PG8_SCHED;
            PG8_LDB(B0, 1, 0); PG8_LDB(B1, 1, 1); PG8_SCHED; PG8_LDA(At, 1, 0); PG8_STAGE(PG8_SA(0, 1), a2 + hstep, voffA);
            PG8_WAIT_V(8); PG8_WAIT_L(0); PG8_BAR; PG8_MMA(0, 0, At, B0); PG8_MMA(0, 1, At, B1); PG8_BAR; PG8_SCHED;
            PG8_LDA(At, 1, 1); PG8_STAGE(PG8_SB(1, 0), b3, voffB); PG8_STAGE(PG8_SB(1, 1), b3 + hstep, voffB); PG8_STAGE(PG8_SA(1, 0), a3, voffA);
            PG8_WAIT_V(8); PG8_WAIT_L(0); PG8_BAR; PG8_MMA(1, 0, At, B0); PG8_MMA(1, 1, At, B1); PG8_BAR; PG8_SCHED;
            } else {
            PG8_LDB(B0, 0, 0); PG8_SCHED; PG8_LDA(At, 0, 0); PG8_STAGE(PG8_SA(1, 1), a1 + hstep, voffA);
            PG8_WAIT_L(8); PG8_BAR; PG8_WAIT_L(0); PG8_MMA(0, 0, At, B0); PG8_BAR; PG8_SCHED;
            PG8_LDB(B1, 0, 1); PG8_STAGE(PG8_SB(0, 0), b2, voffB);
            PG8_BAR; PG8_WAIT_L(0); PG8_MMA(0, 1, At, B1); PG8_BAR;
            PG8_LDA(At, 0, 1); PG8_STAGE(PG8_SA(0, 0), a2, voffA);
            PG8_BAR; PG8_WAIT_L(0); PG8_MMA(1, 0, At, B0); PG8_BAR; PG8_SCHED;
            PG8_STAGE(PG8_SB(0, 1), b2 + hstep, voffB);
            PG8_WAIT_V(6); PG8_BAR; PG8_MMA(1, 1, At, B1); PG8_BAR;
            PG8_LDB(B0, 1, 0); PG8_SCHED; PG8_LDA(At, 1, 0); PG8_STAGE(PG8_SA(0, 1), a2 + hstep, voffA);
            PG8_WAIT_L(8); PG8_BAR; PG8_WAIT_L(0); PG8_MMA(0, 0, At, B0); PG8_BAR; PG8_SCHED;
            PG8_LDB(B1, 1, 1); PG8_STAGE(PG8_SB(1, 0), b3, voffB);
            PG8_BAR; PG8_WAIT_L(0); PG8_MMA(0, 1, At, B1); PG8_BAR;
            PG8_LDA(At, 1, 1); PG8_STAGE(PG8_SA(1, 0), a3, voffA);
            PG8_BAR; PG8_WAIT_L(0); PG8_MMA(1, 0, At, B0); PG8_BAR; PG8_SCHED;
            PG8_STAGE(PG8_SB(1, 1), b3 + hstep, voffB);
            PG8_WAIT_V(6); PG8_BAR; PG8_MMA(1, 1, At, B1); PG8_BAR;
            }
        }
        if constexpr (ALIGN_EPI) { if (wr == 0) PG8_BAR; }
        if constexpr (!Epi::AFTER_DRAIN) { E(acc, cur, wr, wc, fr, fq); S.done(cur); }
        if (!has_next) break;
#pragma unroll
        for (int a = 0; a < 2; ++a)
#pragma unroll
            for (int b = 0; b < 2; ++b)
#pragma unroll
                for (int m = 0; m < 4; ++m)
#pragma unroll
                    for (int n = 0; n < 2; ++n) acc[a][b][m][n] = (f32x4){0.f, 0.f, 0.f, 0.f};
        cur = nxt; cA = nA; cB = nB; ++ui;
        if constexpr (ALIGN_EPI) { if (wr == 1) PG8_BAR; }
    }
    PG8_WAIT_V(0);
    if constexpr (!ALIGN_EPI) { if (wr == 0) PG8_BAR; }
    PG8_BAR;
    if constexpr (Epi::AFTER_DRAIN) { E.fused(acc, cur, wr, wc, fr, fq, lds, wid, lane); S.done(cur); }
#undef PG8_SA
#undef PG8_SB
#undef PG8_STAGE
#undef PG8_LDA
#undef PG8_LDB
#undef PG8_MMA
#undef PG8_WAIT_V
#undef PG8_WAIT_L
#undef PG8_BAR
#undef PG8_SCHED
}
}

constexpr int NWAVES = 8, NTHR = 512;
constexpr int DM = 2048, SEQ = 4096, NB = 2, MP = NB * SEQ  , MS = 32  , MROWS = MP + MS, MPAD = 8448  ;
constexpr int NIN = 7768, NPAD = 7936  ;
constexpr int C_Q = 0, C_K = 1024, C_V = 1280, C_IQ = 1536, C_AZ = 2560, C_MQ = 3584, C_MK = 4096, C_MV = 4608, C_MO = 5632, C_MZ = 6656, C_MISC = 7680;
constexpr int PN_K = 4, PN_V = 5, PN_MK0 = 16, PN_MK1 = 17, PN_MISC = 30;
constexpr int PAST = 16384, PAGE = 128, NPAGES = 128, LS = PAST + 1, SSP = 16640  ;
constexpr float RMS_EPS = 1e-6f;
constexpr int SCP = SEQ + 32, BMP = SEQ + 32, SCPH = SEQ + 64;
constexpr float ATT_C = 0.08838834764831845f * 1.4426950408889634f;
constexpr float MK_SCALE = 0.08838834764831845f;
constexpr size_t O_Y = 0, O_YS = 16777216, O_KP = 16842752, O_VP = 18939904, O_IKP = 21037056, O_CP = 21561344, O_NP = 21823488, O_MPR = 21824512,
                 O_KS = 21824520, O_VS = 21832712, O_IKS = 21840904, O_CS = 21842952, O_NS = 26037256, O_MSS = 26053640, O_END = 26053768;
constexpr size_t MiB = 1u << 20;
constexpr size_t WS_CTL = 0, CTL_ZERO_BYTES = 65536;
constexpr size_t WS_WINT = 2 * MiB;
constexpr size_t WS_WOUTT = 34 * MiB;
constexpr size_t WS_XN = 42 * MiB;
constexpr size_t WS_P = 76 * MiB;
constexpr size_t WS_WI = 204 * MiB;
constexpr size_t WS_IG = 205 * MiB;
constexpr size_t WS_LF = 206 * MiB;
constexpr size_t WS_KIB = 207 * MiB;
constexpr size_t WS_BMT = 210 * MiB;
constexpr size_t WS_MIX = 214 * MiB;
constexpr size_t WS_UN = 248 * MiB;
constexpr size_t WS_CHG = 249 * MiB;
constexpr size_t WS_NST = 250 * MiB;
constexpr size_t WS_MST = 251 * MiB;
constexpr size_t WS_SS = 252 * MiB;
constexpr size_t WS_SIDX = 255 * MiB;
constexpr size_t WS_SC = 256 * MiB;
constexpr size_t WS_UP = 384 * MiB;
constexpr size_t WS_CST = 448 * MiB;
constexpr size_t WS_XCH = 480 * MiB;
constexpr size_t WS_KVC = 482 * MiB;
constexpr size_t WS_SC2 = 492 * MiB;
constexpr size_t WS_BMT2 = 624 * MiB;
constexpr size_t WS_END = 630 * MiB;
constexpr int CW_BAR = 4096;
constexpr int CW_PCNT = 8192, CW_SCNT = 12288;
constexpr int RING_BYTES = 159744, MISC_OFF = RING_BYTES, LDS_BYTES = RING_BYTES + 1024;

#define GAS __attribute__((address_space(1)))
#define LAS __attribute__((address_space(3)))
typedef unsigned short bf16;
typedef unsigned v4u __attribute__((ext_vector_type(4)));
typedef unsigned v2u __attribute__((ext_vector_type(2)));
typedef _Float16 h16x2 __attribute__((ext_vector_type(2)));
typedef float f32x4 __attribute__((ext_vector_type(4)));
typedef float f32x2 __attribute__((ext_vector_type(2)));
typedef float f32x16 __attribute__((ext_vector_type(16)));
typedef short bf16x8 __attribute__((ext_vector_type(8)));
typedef short s16x4 __attribute__((ext_vector_type(4)));
#define LDS_WAIT() asm volatile("s_waitcnt lgkmcnt(0)" ::: "memory")
#define VM_WAIT() asm volatile("s_waitcnt vmcnt(0)" ::: "memory")
__device__ __forceinline__ unsigned f2bf(float f) { unsigned u = __builtin_bit_cast(unsigned, f); return (u + 0x7fffu + ((u >> 16) & 1u)) >> 16; }
__device__ __forceinline__ unsigned pk2(float lo, float hi) { return f2bf(lo) | (f2bf(hi) << 16); }
__device__ __forceinline__ float bflo(unsigned w) { return __builtin_bit_cast(float, w << 16); }
__device__ __forceinline__ float bfhi(unsigned w) { return __builtin_bit_cast(float, w & 0xffff0000u); }
__device__ __forceinline__ float bf1(bf16 b) { return __builtin_bit_cast(float, (unsigned)b << 16); }
__device__ __forceinline__ float wave_sum(float v) {
#pragma unroll
    for (int o = 1; o < 64; o <<= 1) v += __shfl_xor(v, o);
    return v;
}
__device__ __forceinline__ float wave_max(float v) {
#pragma unroll
    for (int o = 1; o < 64; o <<= 1) v = fmaxf(v, __shfl_xor(v, o));
    return v;
}
__device__ __forceinline__ float sigmoidf_(float x) { return __builtin_amdgcn_rcpf(1.f + __expf(-x)); }
__device__ __forceinline__ float siluf_(float x) { return x * __builtin_amdgcn_rcpf(1.f + __expf(-x)); }
typedef __bf16 bf16x2_t __attribute__((ext_vector_type(2)));
__device__ __forceinline__ unsigned cvt2(float a, float b) { f32x2 v = {a, b}; bf16x2_t r = __builtin_convertvector(v, bf16x2_t); return __builtin_bit_cast(unsigned, r); }
#define MFMA32(a, b, c) __builtin_amdgcn_mfma_f32_32x32x16_bf16((a), (b), (c), 0, 0, 0)
__device__ __forceinline__ f32x16 zero16() { f32x16 z; _Pragma("unroll") for (int i = 0; i < 16; ++i) z[i] = 0.f; return z; }
__device__ __forceinline__ s16x4 tr_read4(LAS unsigned char* base, int row0, int col0, int rp, int lane) {
    const int q = (lane & 15) >> 2, p = lane & 3;
    return __builtin_amdgcn_ds_read_tr16_b64_v4i16((LAS s16x4*)(base + (row0 + q) * rp + (col0 + 4 * p) * 2));
}
__device__ __forceinline__ bf16x8 cat8(s16x4 lo, s16x4 hi) { return __builtin_shufflevector(lo, hi, 0, 1, 2, 3, 4, 5, 6, 7); }


__device__ __forceinline__ int wave_sum_i(int x) {
    x += __builtin_amdgcn_update_dpp(0, x, 0xB1, 0xF, 0xF, true);
    x += __builtin_amdgcn_update_dpp(0, x, 0x4E, 0xF, 0xF, true);
    x += __builtin_amdgcn_update_dpp(0, x, 0x141, 0xF, 0xF, true);
    x += __builtin_amdgcn_update_dpp(0, x, 0x140, 0xF, 0xF, true);
    return __builtin_amdgcn_readlane(x, 0) + __builtin_amdgcn_readlane(x, 16) + __builtin_amdgcn_readlane(x, 32) + __builtin_amdgcn_readlane(x, 48);
}
__device__ __forceinline__ float row16_sum(float v) {
    v += __builtin_bit_cast(float, __builtin_amdgcn_update_dpp(0, __builtin_bit_cast(int, v), 0xB1, 0xF, 0xF, true));
    v += __builtin_bit_cast(float, __builtin_amdgcn_update_dpp(0, __builtin_bit_cast(int, v), 0x4E, 0xF, 0xF, true));
    v += __builtin_bit_cast(float, __builtin_amdgcn_update_dpp(0, __builtin_bit_cast(int, v), 0x141, 0xF, 0xF, true));
    v += __builtin_bit_cast(float, __builtin_amdgcn_update_dpp(0, __builtin_bit_cast(int, v), 0x140, 0xF, 0xF, true));
    return v;
}

__device__ __forceinline__ float xhalf_max(float x) { return fmaxf(x, __shfl_xor(x, 32)); }
__device__ __forceinline__ float xhalf_sum(float x) { return x + __shfl_xor(x, 32); }

__device__ __forceinline__ void st_wt16(void* p, v4u v) { asm volatile("global_store_dwordx4 %0, %1, off sc0 sc1\n\ts_nop 0" :: "v"(p), "v"(v) : "memory"); }
__device__ __forceinline__ void st_wt8(void* p, v2u v) { asm volatile("global_store_dwordx2 %0, %1, off sc0 sc1\n\ts_nop 0" :: "v"(p), "v"(v) : "memory"); }
__device__ __forceinline__ void st_wt4(void* p, unsigned v) { asm volatile("global_store_dword %0, %1, off sc0 sc1\n\ts_nop 0" :: "v"(p), "v"(v) : "memory"); }
#define XB_TMO      128
#define XB_XCNT(j)  (256  + 64 * (j))
#define XB_XSUB(j)  (1280 + 64 * (j))
#define XB_XGEN(j)  (2304 + 64 * (j))
#define XB_TOP      3328
#define XB_TOPGEN   3392
#define XCD_BAR_WORDS 3456
#define XB_SPIN_CAP (1u << 18)

__device__ __forceinline__ unsigned xb_ld(unsigned* p)              { return __hip_atomic_load(p, __ATOMIC_RELAXED, __HIP_MEMORY_SCOPE_AGENT); }
__device__ __forceinline__ unsigned xb_add(unsigned* p, unsigned v) { return __hip_atomic_fetch_add(p, v, __ATOMIC_RELAXED, __HIP_MEMORY_SCOPE_AGENT); }
__device__ __forceinline__ unsigned xb_xcc_id() { return (unsigned)__builtin_amdgcn_s_getreg((3 << 11) | 20) & 0xFu; }
#define XB_SPIN(cond, bar) do { unsigned _sp = 0; while (cond) { __builtin_amdgcn_s_sleep(1); \
    if ((++_sp & 255u) == 0u) { if (xb_ld(&(bar)[XB_TMO])) break; if (_sp > XB_SPIN_CAP) { atomicAdd(&(bar)[XB_TMO], 1u); break; } } } } while (0)

struct XcdBarrier {
    unsigned* bar; unsigned x;
    volatile LAS unsigned* st;
};

__device__ __forceinline__ XcdBarrier xcd_barrier_post(unsigned* bar, volatile LAS unsigned* st) {
    XcdBarrier b; b.bar = bar; b.x = xb_xcc_id(); b.st = st;
    if (threadIdx.x == 0) (void)xb_add(&bar[XB_XCNT(b.x)], 1u);
    return b;
}
__device__ __forceinline__ void xcd_barrier_complete(unsigned* bar, unsigned x, unsigned& nloc, unsigned& nx) {
    const unsigned G = gridDim.x * gridDim.y * gridDim.z;
    unsigned sum, cnt, mine, sp = 0u;
    for (;;) {
        sum = 0u; cnt = 0u; mine = 0u;
#pragma unroll
        for (unsigned j = 0; j < 16; ++j) { const unsigned c = xb_ld(&bar[XB_XCNT(j)]); sum += c; cnt += (c > 0u) ? 1u : 0u; mine = (j == x) ? c : mine; }
        if (sum == G) break;
        __builtin_amdgcn_s_sleep(1);
        if ((++sp & 255u) == 0u) { if (xb_ld(&bar[XB_TMO])) break; if (sp > XB_SPIN_CAP) { atomicAdd(&bar[XB_TMO], 1u); break; } }
    }
    nloc = mine > 0u ? mine : 1u; nx = cnt > 0u ? cnt : 1u;
}

__device__ __forceinline__ void xcd_barrier(const XcdBarrier& b) {
    asm volatile("s_waitcnt vmcnt(0)" ::: "memory");
    __syncthreads();
    if (threadIdx.x == 0) {
        unsigned* bar = b.bar;
        __builtin_amdgcn_s_waitcnt(0);
        unsigned nloc = b.st[0], nx = b.st[1];
        if (nloc == 0u) { xcd_barrier_complete(bar, b.x, nloc, nx); b.st[0] = nloc; b.st[1] = nx; }
        const unsigned old = xb_add(&bar[XB_XSUB(b.x)], 1u);
        const unsigned gen = old / nloc;
        if (old + 1u == (gen + 1u) * nloc) {
            __builtin_amdgcn_fence(__ATOMIC_RELEASE, "agent");
            asm volatile("s_waitcnt vmcnt(0)" ::: "memory");
            const unsigned og = xb_add(&bar[XB_TOP], 1u);
            const unsigned tg = og / nx;
            if (og + 1u == (tg + 1u) * nx) xb_add(&bar[XB_TOPGEN], 1u);
            else XB_SPIN(xb_ld(&bar[XB_TOPGEN]) == tg, bar);
            __builtin_amdgcn_fence(__ATOMIC_ACQUIRE, "agent");
            xb_add(&bar[XB_XGEN(b.x)], 1u);
            asm volatile("s_waitcnt vmcnt(0)" ::: "memory");
        } else {
            XB_SPIN(xb_ld(&bar[XB_XGEN(b.x)]) == gen, bar);
            __builtin_amdgcn_fence(__ATOMIC_ACQUIRE, "agent");
            asm volatile("s_waitcnt vmcnt(0)" ::: "memory");
        }
    }
    __syncthreads();
}
struct Frame {
    LAS unsigned char* lds;
    int tid, lane, wave;
    int vcu, G;
    const float *x_prompt, *x_sample, *cache_k, *cache_v, *cache_ik, *state_C, *state_n, *state_m;
    const int* page_table;
    const float *norm_w, *w_in, *b_i, *b_f, *ml_norm_w, *w_out, *final_norm_w;
    float* out;
    bf16 *WINT, *WOUTT, *XN, *P, *KIB, *MIX, *CST, *KVC;
    float *WI, *IG, *LF, *UN, *CHG, *NST, *MST, *SS, *SC, *UP;
    unsigned* BMT; int* SIDX;
    XcdBarrier* bar;
    float* XCH; unsigned* ctl; int two;
};
#ifndef DUP_SUB
#define DUP_SUB 0
#endif
#define REPEAT(id) for (int rep_ = 0, nrep_ = (DUP_SUB == (id)) ? F.two : 1; rep_ < nrep_; ++rep_)
#define REP_BAR() do { if (nrep_ > 1) xcd_barrier(*F.bar); } while (0)

__device__ __forceinline__ int win_origcol(int c) {
    if (c < 2560) return c;
    if (c < 5632) return c + 80;
    if (c < 7680) return c + 88;
    if (c < 7744) return 2560 + (c - 7680);
    if (c < 7760) return 2624 + (c - 7744);
    if (c < 7764) return 5712 + (c - 7760);
    if (c < 7768) return 5716 + (c - 7764);
    return -1;
}
template <bool REMAP>
__device__ __forceinline__ void p0_transpose_item(const float* W, int K, int Nsrc, int N, bf16* WT, LAS float* scr, int item, int lane) {
    const int nblk = N / 32, kb = item / nblk, nb = item % nblk, k0 = 64 * kb, n0 = 32 * nb;
    const int mycol = n0 + (lane & 31); const int oc = REMAP ? win_origcol(mycol) : mycol;
    float wv[32];
#pragma unroll
    for (int i = 0; i < 32; ++i) wv[i] = (oc >= 0) ? __builtin_nontemporal_load(W + (size_t)(k0 + 2 * i + (lane >> 5)) * Nsrc + oc) : 0.f;
#pragma unroll
    for (int i = 0; i < 32; ++i) scr[(2 * i + (lane >> 5)) * 33 + (lane & 31)] = wv[i];
    LDS_WAIT(); asm volatile("" ::: "memory");
    const int c = lane & 7;
#pragma unroll
    for (int j = 0; j < 4; ++j) { const int n = (lane >> 3) + 8 * j; const LAS float* s = scr + (8 * c) * 33 + n;
        v4u o; o.x = cvt2(s[0 * 33], s[1 * 33]); o.y = cvt2(s[2 * 33], s[3 * 33]); o.z = cvt2(s[4 * 33], s[5 * 33]); o.w = cvt2(s[6 * 33], s[7 * 33]);
        *(GAS v4u*)(WT + (size_t)(n0 + n) * K + k0 + 8 * c) = o; }
    LDS_WAIT(); asm volatile("" ::: "memory");
}
__device__ __forceinline__ void rms_row_to_bf16(const float* xrow, const float* w, bf16* orow, int lane) {
    const GAS f32x4* xr = (const GAS f32x4*)xrow + lane; const GAS f32x4* wr = (const GAS f32x4*)w + lane;
    f32x4 v[8]; float s = 0.f;
#pragma unroll
    for (int j = 0; j < 8; ++j) { v[j] = xr[64 * j]; s += (v[j].x * v[j].x + v[j].y * v[j].y) + (v[j].z * v[j].z + v[j].w * v[j].w); }
    const float rstd = 1.f / sqrtf(wave_sum(s) * (1.f / DM) + RMS_EPS);
    GAS v2u* o8 = (GAS v2u*)orow + lane;
#pragma unroll
    for (int j = 0; j < 8; ++j) { const f32x4 ww = wr[64 * j]; v2u o; o.x = cvt2(v[j].x * rstd * ww.x, v[j].y * rstd * ww.y); o.y = cvt2(v[j].z * rstd * ww.z, v[j].w * rstd * ww.w); o8[64 * j] = o; }
}
__device__ __forceinline__ void p0_prologue(Frame& F) {
    LAS float* scr = (LAS float*)(F.lds + F.wave * 16384);
    const int gw = F.vcu * NWAVES + F.wave, NGW = F.G * NWAVES;
    constexpr int I_IN = (DM / 64) * (NPAD / 32), I_OUT = (DM / 64) * (DM / 32);
    for (int it = gw; it < I_IN + I_OUT; it += NGW) {
        if (it < I_IN) p0_transpose_item<true>(F.w_in, DM, NIN, NPAD, F.WINT, scr, it, F.lane);
        else p0_transpose_item<false>(F.w_out, DM, DM, DM, F.WOUTT, scr, it - I_IN, F.lane);
    }
    auto rowsrc = [&](int m) -> const float* { return (m < MP) ? F.x_prompt + (size_t)m * DM : F.x_sample + (size_t)(m - MP) * DM; };
    f32x4 va[8], vb[8], wn[8];
    { const GAS f32x4* wr = (const GAS f32x4*)F.norm_w + F.lane;
#pragma unroll
      for (int j = 0; j < 8; ++j) wn[j] = wr[64 * j]; }
    int m = gw;
    if (m < MROWS) { const GAS f32x4* xr = (const GAS f32x4*)rowsrc(m) + F.lane;
#pragma unroll
        for (int j = 0; j < 8; ++j) va[j] = __builtin_nontemporal_load(xr + 64 * j); }
#pragma unroll 1
    for (; m < MROWS; m += NGW) {
        const int mn = m + NGW;
        if (mn < MROWS) { const GAS f32x4* xr = (const GAS f32x4*)rowsrc(mn) + F.lane;
#pragma unroll
            for (int j = 0; j < 8; ++j) vb[j] = __builtin_nontemporal_load(xr + 64 * j); }
        float s = 0.f;
#pragma unroll
        for (int j = 0; j < 8; ++j) s += (va[j].x * va[j].x + va[j].y * va[j].y) + (va[j].z * va[j].z + va[j].w * va[j].w);
        const float rstd = 1.f / sqrtf(wave_sum(s) * (1.f / DM) + RMS_EPS);
        GAS v2u* o8 = (GAS v2u*)(F.XN + (size_t)m * DM) + F.lane;
#pragma unroll
        for (int j = 0; j < 8; ++j) { const f32x4 ww = wn[j]; v2u o; o.x = cvt2(va[j].x * rstd * ww.x, va[j].y * rstd * ww.y); o.y = cvt2(va[j].z * rstd * ww.z, va[j].w * rstd * ww.w); o8[64 * j] = o; }
#pragma unroll
        for (int j = 0; j < 8; ++j) va[j] = vb[j];
    }
    for (int mz = MROWS + gw; mz < MPAD; mz += NGW) { GAS v4u* o = (GAS v4u*)(F.XN + (size_t)mz * DM) + F.lane;
#pragma unroll
        for (int j = 0; j < 4; ++j) o[64 * j] = (v4u){0u, 0u, 0u, 0u}; }
}

__device__ __forceinline__ float log_sigmoidf_(float x) { return fminf(x, 0.f) - log1pf(__expf(-fabsf(x))); }
struct EpiIn {
    static constexpr bool PERM = true, AFTER_DRAIN = false;
    bf16* P; float* out; float* WI; float* IG; float* LF; bf16* KIB; const float* b_i; const float* b_f; bf16* KVC;
    __device__ __forceinline__ void operator()(const pg8::f32x4 (&acc)[2][2][4][2], const pg8::Unit& u, int wr, int wc, int fr, int fq) const {
        const int row0 = u.pm * 256 + wr * 64 + fr, g8 = wc * 32 + 8 * fq, col0 = u.pn * 256 + g8;
        const float sc = (u.pn == PN_MK0 || u.pn == PN_MK1) ? MK_SCALE : 1.f;
#pragma unroll
        for (int ai = 0; ai < 2; ++ai)
#pragma unroll
            for (int m = 0; m < 4; ++m) {
                const int row = row0 + ai * 128 + m * 16;
                if (row < MROWS) {
                    bf16* rowp = P + (size_t)row * NPAD + col0;
#pragma unroll
                    for (int bj = 0; bj < 2; ++bj) { const f32x4 v0 = acc[ai][bj][m][0] * sc, v1 = acc[ai][bj][m][1] * sc;
                        v4u w; w.x = pg8::cvt_pk_bf16(v0[0], v0[1]); w.y = pg8::cvt_pk_bf16(v0[2], v0[3]); w.z = pg8::cvt_pk_bf16(v1[0], v1[1]); w.w = pg8::cvt_pk_bf16(v1[2], v1[3]);
                        *(v4u*)(rowp + bj * 128) = w; }
                    if (u.pn == PN_K || u.pn == PN_V) {
                        float* dst = (row < MP) ? out + (u.pn == PN_K ? O_KP : O_VP) + (size_t)row * 256 : out + (u.pn == PN_K ? O_KS : O_VS) + (size_t)(row - MP) * 256;
#pragma unroll
                        for (int bj = 0; bj < 2; ++bj) { *(f32x4*)(dst + g8 + bj * 128) = acc[ai][bj][m][0]; *(f32x4*)(dst + g8 + bj * 128 + 4) = acc[ai][bj][m][1]; }
                        if (row < MP) {
#pragma unroll
                            for (int bj = 0; bj < 2; ++bj) { const f32x4 v0 = acc[ai][bj][m][0], v1 = acc[ai][bj][m][1];
                                v4u w; w.x = pg8::cvt_pk_bf16(v0[0], v0[1]); w.y = pg8::cvt_pk_bf16(v0[2], v0[3]); w.z = pg8::cvt_pk_bf16(v1[0], v1[1]); w.w = pg8::cvt_pk_bf16(v1[2], v1[3]);
                                *(v4u*)(KVC + ((size_t)(((row >> 12) * 2 + bj) * SEQ + (row & 4095))) * 256 + (u.pn == PN_V ? 128 : 0) + g8) = w; }
                        }
                    }
                    if (u.pn == PN_MISC) {
                        const f32x4 v0 = acc[ai][0][m][0], v1 = acc[ai][0][m][1];
                        if (g8 < 64) {
                            float* dst = (row < MP) ? out + O_IKP + (size_t)row * 64 : out + O_IKS + (size_t)(row - MP) * 64;
                            *(f32x4*)(dst + g8) = v0; *(f32x4*)(dst + g8 + 4) = v1;
                            v4u w; w.x = pg8::cvt_pk_bf16(v0[0], v0[1]); w.y = pg8::cvt_pk_bf16(v0[2], v0[3]); w.z = pg8::cvt_pk_bf16(v1[0], v1[1]); w.w = pg8::cvt_pk_bf16(v1[2], v1[3]);
                            *(v4u*)(KIB + (size_t)row * 64 + g8) = w;
                        } else if (g8 < 80) {
                            *(f32x4*)(WI + (size_t)row * 16 + (g8 - 64)) = v0; *(f32x4*)(WI + (size_t)row * 16 + (g8 - 64) + 4) = v1;
                        } else if (g8 == 80) {
                            f32x4 ig, lf;
#pragma unroll
                            for (int j = 0; j < 4; ++j) { ig[j] = v0[j] + b_i[j]; lf[j] = log_sigmoidf_(v1[j] + b_f[j]); }
                            *(f32x4*)(IG + (size_t)row * 4) = ig; *(f32x4*)(LF + (size_t)row * 4) = lf;
                        }
                    }
                }
            }
    }
};
constexpr int P2_NS = 128, P2_WA = 5;
constexpr int IXPAD = 32;
constexpr int RPQ = 2192;
template <int MODE>
__device__ __forceinline__ void p2_indexer(Frame& F) {
    const int lane = F.lane, r = lane & 31, hh = lane >> 5;
    LAS float* wl = (LAS float*)(F.lds + 32 * RPQ);
    constexpr int TPB = 128 * 129 / 2, VPB = TPB + 128 * IXPAD, VTOT = 2 * VPB;
    const int ns = (F.G == 256) ? P2_NS : 0;
    auto cumw = [&](int i) -> long { return i < ns ? (long)i * P2_WA : (long)ns * P2_WA + (long)(i - ns) * 16; };
    const long totw = cumw(F.G);
    const int lo = (int)((long)VTOT * cumw(blockIdx.x) / totw), hi = (int)((long)VTOT * cumw(blockIdx.x + 1) / totw);
    int idx = lo;
    while (idx < hi) {
        const int b = idx / VPB, rr = idx % VPB;
        int qt = (int)((sqrtf((float)((2 * IXPAD + 1) * (2 * IXPAD + 1)) + 8.f * (float)rr) - (float)(2 * IXPAD + 1)) * 0.5f);
        while (qt * (qt + 1) / 2 + IXPAD * qt > rr) --qt;
        while ((qt + 1) * (qt + 2) / 2 + IXPAD * (qt + 1) <= rr) ++qt;
        const int off = rr - (qt * (qt + 1) / 2 + IXPAD * qt);
        const int rowend = idx - off + IXPAD + qt + 1;
        const int kt0 = off > IXPAD ? off - IXPAD : 0;
        const int nk = (rowend < hi ? rowend : hi) - (idx - off + IXPAD + kt0);
        idx = rowend;
        if (nk <= 0) continue;
        const int qrow0 = b * SEQ + 32 * qt;
        __syncthreads();
#pragma unroll
        for (int i = 0; i < 8; ++i) { const int ch = F.tid + 512 * i, row = ch >> 7, c16 = ch & 127;
            const v4u v = *(const GAS v4u*)(F.P + (size_t)(qrow0 + row) * NPAD + C_IQ + 8 * c16);
            *(LAS v4u*)(F.lds + row * RPQ + 16 * c16) = v; }
        __syncthreads();
        { const int q = F.tid >> 4, d4 = (F.tid & 15) * 4;
          const float* wi = F.WI + (size_t)(qrow0 + q) * 16;
          float a0 = 0.f, a1 = 0.f, a2 = 0.f, a3 = 0.f;
#pragma unroll
          for (int h = 0; h < 16; ++h) { const float w = wi[h]; const v2u x = *(LAS v2u*)(F.lds + q * RPQ + (h * 64 + d4) * 2);
              a0 += w * bflo(x.x); a1 += w * bfhi(x.x); a2 += w * bflo(x.y); a3 += w * bfhi(x.y); }
          v2u o; o.x = cvt2(a0, a1); o.y = cvt2(a2, a3); *(LAS v2u*)(F.lds + q * RPQ + (1024 + d4) * 2) = o;
          wl[q * 17 + (F.tid & 15)] = wi[F.tid & 15]; }
        __syncthreads();
        LAS unsigned char* qb = F.lds + r * RPQ + 16 * hh;
#define IX_LDB(dst, off) do { _Pragma("unroll") for (int s_ = 0; s_ < 4; ++s_) dst[s_] = *(LAS bf16x8*)(qb + (off) + 32 * s_); } while (0)
#define IX_LDA(dst, kt_) do { const bf16* ap_ = F.KIB + (size_t)(b * SEQ + 32 * (kt_) + r) * 64 + 8 * hh; _Pragma("unroll") for (int s_ = 0; s_ < 4; ++s_) dst[s_] = *(const GAS bf16x8*)(ap_ + 16 * s_); } while (0)
        bf16x8 A[4], An[4];
        if (F.wave < nk) IX_LDA(A, kt0 + F.wave);
        for (int kk = F.wave; kk < nk; kk += NWAVES) {
            const int kt = kt0 + kk;
            asm volatile("" ::: "memory");
            if (kk + NWAVES < nk) IX_LDA(An, kt + NWAVES);
            bf16x8 Ba[4], Bb[4];
            IX_LDB(Ba, 2048);
            IX_LDB(Bb, 0);
            f32x16 acc = zero16();
#pragma unroll
            for (int s = 0; s < 4; ++s) acc = MFMA32(A[s], Ba[s], acc);
            f32x16 Ta = zero16(), Tb;
#pragma unroll
            for (int s = 0; s < 4; ++s) Ta = MFMA32(A[s], Bb[s], Ta);
            IX_LDB(Bb, 128);
#define IX_FMA8(T, o, wv) asm volatile("s_nop 1\n\tv_fma_f32 %0, %8, |%9|, %0\n\tv_fma_f32 %1, %8, |%10|, %1\n\tv_fma_f32 %2, %8, |%11|, %2\n\tv_fma_f32 %3, %8, |%12|, %3\n\t" \
                "v_fma_f32 %4, %8, |%13|, %4\n\tv_fma_f32 %5, %8, |%14|, %5\n\tv_fma_f32 %6, %8, |%15|, %6\n\tv_fma_f32 %7, %8, |%16|, %7" \
                : "+v"(acc[o]), "+v"(acc[o + 1]), "+v"(acc[o + 2]), "+v"(acc[o + 3]), "+v"(acc[o + 4]), "+v"(acc[o + 5]), "+v"(acc[o + 6]), "+v"(acc[o + 7]) \
                : "v"(wv), "v"(T[o]), "v"(T[o + 1]), "v"(T[o + 2]), "v"(T[o + 3]), "v"(T[o + 4]), "v"(T[o + 5]), "v"(T[o + 6]), "v"(T[o + 7]))
#pragma unroll 1
            for (int hp = 0; hp < (MODE == 2 ? 1 : 8); ++hp) {
                const float w0 = wl[r * 17 + 2 * hp], w1 = wl[r * 17 + 2 * hp + 1];
                Tb = zero16();
#pragma unroll
                for (int s = 0; s < 4; ++s) Tb = MFMA32(A[s], Bb[s], Tb);
                if (hp < 7) IX_LDB(Ba, (2 * hp + 2) * 128);
                IX_FMA8(Ta, 0, w0); IX_FMA8(Ta, 8, w0);
                Ta = zero16();
                if (hp < 7) {
#pragma unroll
                    for (int s = 0; s < 4; ++s) Ta = MFMA32(A[s], Ba[s], Ta);
                    IX_LDB(Bb, (2 * hp + 3) * 128);
                }
                IX_FMA8(Tb, 0, w1); IX_FMA8(Tb, 8, w1);
            }
#undef IX_FMA8
            { LAS unsigned char* tw = F.lds + 73728 + F.wave * 4608;
#pragma unroll
              for (int g = 0; g < 4; ++g) { const h16x2 p0 = {(_Float16)(acc[4 * g] * 0.015625f), (_Float16)(acc[4 * g + 1] * 0.015625f)}, p1 = {(_Float16)(acc[4 * g + 2] * 0.015625f), (_Float16)(acc[4 * g + 3] * 0.015625f)};
                  v2u o; o.x = __builtin_bit_cast(unsigned, p0); o.y = __builtin_bit_cast(unsigned, p1); *(LAS v2u*)(tw + r * 80 + (8 * g + 4 * hh) * 2) = o; }
              unsigned short* dst = (unsigned short*)F.SC + (size_t)(qrow0 + (lane >> 2)) * SCPH + 32 * kt + 8 * (lane & 3);
#pragma unroll
              for (int i = 0; i < 2; ++i) *(GAS v4u*)(dst + (size_t)(16 * i) * SCPH) = *(LAS v4u*)(tw + ((lane >> 2) + 16 * i) * 80 + (lane & 3) * 16); }
#pragma unroll
            for (int s = 0; s < 4; ++s) A[s] = An[s];
        }
#undef IX_LDB
#undef IX_LDA
    }
    __syncthreads();
}

constexpr int RPK = 320, RPV = 576;
constexpr int ML_KOFF = 0, ML_VOFF = 64 * RPK  , ML_WOFF = ML_VOFF + 64 * RPV  ;
struct MlaRegs { v4u k[2]; v4u v[4]; float ig, lf; };
__device__ __forceinline__ void p2_mlstm_a_load(Frame& F, int unit, MlaRegs& R) {
    const int c = unit & 63, h = (unit >> 6) & 3, b = unit >> 8, row0 = b * SEQ + 64 * c;
    if (F.wave == 0) { R.ig = F.IG[(size_t)(row0 + F.lane) * 4 + h]; R.lf = F.LF[(size_t)(row0 + F.lane) * 4 + h]; }
#pragma unroll
    for (int i = 0; i < 2; ++i) { const int ch = F.tid + 512 * i, s = ch >> 4, c16 = ch & 15; R.k[i] = *(const GAS v4u*)(F.P + (size_t)(row0 + s) * NPAD + C_MK + h * 128 + 8 * c16); }
#pragma unroll
    for (int i = 0; i < 4; ++i) { const int ch = F.tid + 512 * i, s = ch >> 5, c16 = ch & 31; R.v[i] = *(const GAS v4u*)(F.P + (size_t)(row0 + s) * NPAD + C_MV + h * 256 + 8 * c16); }
}
__device__ __forceinline__ void p2_mlstm_a(Frame& F, int unit, const MlaRegs& R, int next_unit, MlaRegs& Rn) {
    const int lane = F.lane, hh = lane >> 5;
    LAS float* wl = (LAS float*)(F.lds + ML_WOFF);
    __syncthreads();
    if (F.wave == 0) {
        float bc = R.lf;
#pragma unroll
        for (int o = 1; o < 64; o <<= 1) { const float t = __shfl_up(bc, o); if (lane >= o) bc += t; }
        const float g = R.ig - bc, G = wave_max(g);
        wl[lane] = __expf(g - G);
        if (lane == 63) { F.CHG[unit] = G; F.CHG[512 + unit] = bc; }
    }
    __syncthreads();
#pragma unroll
    for (int i = 0; i < 2; ++i) { const int ch = F.tid + 512 * i, s = ch >> 4, c16 = ch & 15;
        const v4u v = R.k[i]; const float ws = wl[s];
        v4u o; o.x = cvt2(bflo(v.x) * ws, bfhi(v.x) * ws); o.y = cvt2(bflo(v.y) * ws, bfhi(v.y) * ws); o.z = cvt2(bflo(v.z) * ws, bfhi(v.z) * ws); o.w = cvt2(bflo(v.w) * ws, bfhi(v.w) * ws);
        *(LAS v4u*)(F.lds + ML_KOFF + s * RPK + 16 * c16) = o; }
#pragma unroll
    for (int i = 0; i < 4; ++i) { const int ch = F.tid + 512 * i, s = ch >> 5, c16 = ch & 31;
        *(LAS v4u*)(F.lds + ML_VOFF + s * RPV + 16 * c16) = R.v[i]; }
    if (next_unit >= 0) p2_mlstm_a_load(F, next_unit, Rn);
    __syncthreads();
    if (F.tid < 128) { float a = 0.f;
#pragma unroll 8
        for (int s = 0; s < 64; ++s) a += bf1(*(LAS bf16*)(F.lds + ML_KOFF + s * RPK + 2 * F.tid));
        F.UN[(size_t)unit * 128 + F.tid] = a; }
    const int blk = (lane >> 4) & 1;
    bf16x8 Af[4];
#pragma unroll
    for (int ks = 0; ks < 4; ++ks) Af[ks] = cat8(tr_read4(F.lds + ML_VOFF, 16 * ks + 8 * hh, 32 * F.wave + 16 * blk, RPV, lane), tr_read4(F.lds + ML_VOFF, 16 * ks + 8 * hh + 4, 32 * F.wave + 16 * blk, RPV, lane));
    LAS unsigned char* ut = F.lds + 59392 + F.wave * 8704;
#pragma unroll
    for (int dt = 0; dt < 4; ++dt) {
        f32x16 acc = zero16();
#pragma unroll
        for (int ks = 0; ks < 4; ++ks) {
            const bf16x8 Bf = cat8(tr_read4(F.lds + ML_KOFF, 16 * ks + 8 * hh, 32 * dt + 16 * blk, RPK, lane), tr_read4(F.lds + ML_KOFF, 16 * ks + 8 * hh + 4, 32 * dt + 16 * blk, RPK, lane));
            acc = MFMA32(Af[ks], Bf, acc);
        }
#pragma unroll
        for (int i = 0; i < 16; ++i) *(LAS bf16*)(ut + ((i & 3) + 8 * (i >> 2) + 4 * hh) * 272 + (32 * dt + (lane & 31)) * 2) = (bf16)f2bf(acc[i]);
    }
    bf16* upb = (bf16*)F.UP + (size_t)unit * 32768 + (size_t)(32 * F.wave) * 128;
#pragma unroll
    for (int i = 0; i < 8; ++i) { const int row = (lane >> 4) + 4 * i; *(GAS v4u*)(upb + row * 128 + 8 * (lane & 15)) = *(LAS v4u*)(ut + row * 272 + 16 * (lane & 15)); }
}
__device__ __forceinline__ void p2_mlstm_a_all(Frame& F) {
    MlaRegs Ra, Rb;
    int u = blockIdx.x;
    if (u < 512) p2_mlstm_a_load(F, u, Ra);
#pragma unroll 1
    for (; u < 512; u += 2 * F.G) {
        const int u1 = u + F.G, u2 = u + 2 * F.G;
        p2_mlstm_a(F, u, Ra, (u1 < 512) ? u1 : -1, Rb);
        if (u1 < 512) p2_mlstm_a(F, u1, Rb, (u2 < 512) ? u2 : -1, Ra);
    }
}

__device__ __forceinline__ void p2_sample_scores(Frame& F) {
    const int lane = F.lane, c = lane & 31, hh = lane >> 5;
    const int nsw = (F.G == 256) ? P2_NS : F.G;
    if ((int)blockIdx.x >= nsw) return;
    const int gw = blockIdx.x * NWAVES + F.wave, NGW = nsw * NWAVES;
    int page_nx = (gw < MS * NPAGES) ? F.page_table[(gw >> 7) * NPAGES + (gw & 127)] : 0;
    for (int task = gw; task < MS * NPAGES; task += NGW) {
        const int s = task >> 7, pg = task & 127;
        bf16x8 qB[4];
        { const bf16* qp = F.P + (size_t)(MP + s) * NPAD + C_IQ + (c & 15) * 64 + 8 * hh;
#pragma unroll
          for (int k = 0; k < 4; ++k) { const v4u x = *(const GAS v4u*)(qp + 16 * k); qB[k] = __builtin_bit_cast(bf16x8, (c < 16) ? x : (v4u){0u, 0u, 0u, 0u}); } }
        const float w = (c < 16) ? F.WI[(size_t)(MP + s) * 16 + (c & 15)] : 0.f;
        const int page = page_nx;
        { const int tn = task + NGW; page_nx = (tn < MS * NPAGES) ? F.page_table[(tn >> 7) * NPAGES + (tn & 127)] : 0; }
        const float* pb = F.cache_ik + (size_t)page * PAGE * 64 + 4 * lane;
        LAS unsigned char* wb = F.lds + F.wave * 8704;
        f32x4 Pg[32];
#pragma unroll
        for (int i = 0; i < 32; ++i) Pg[i] = __builtin_nontemporal_load((const GAS f32x4*)(pb + 256 * i));
#pragma unroll
        for (int kb = 0; kb < 4; ++kb) {
#pragma unroll
            for (int i = 0; i < 8; ++i) *(LAS f32x4*)(wb + (4 * i + (lane >> 4)) * 272 + (lane & 15) * 16) = Pg[8 * kb + i];
            f32x16 acc = zero16();
#pragma unroll
            for (int k = 0; k < 4; ++k) { const f32x4 a0 = *(LAS f32x4*)(wb + c * 272 + (16 * k + 8 * hh) * 4), a1 = *(LAS f32x4*)(wb + c * 272 + (16 * k + 8 * hh) * 4 + 16);
                v4u a; a.x = cvt2(a0.x, a0.y); a.y = cvt2(a0.z, a0.w); a.z = cvt2(a1.x, a1.y); a.w = cvt2(a1.z, a1.w);
                acc = MFMA32(__builtin_bit_cast(bf16x8, a), qB[k], acc); }
#pragma unroll
            for (int i = 0; i < 16; ++i) acc[i] = row16_sum(w * fmaxf(acc[i], 0.f));
            if (c == 0) { float* dst = F.SS + (size_t)s * SSP + pg * PAGE + 32 * kb + 4 * hh;
#pragma unroll
                for (int g = 0; g < 4; ++g) *(f32x4*)(dst + 8 * g) = (f32x4){acc[4 * g], acc[4 * g + 1], acc[4 * g + 2], acc[4 * g + 3]}; }
        }
        if (pg == 0) {
            const float kn = F.out[O_IKS + (size_t)s * 64 + lane];
            const bf16* qp = F.P + (size_t)(MP + s) * NPAD + C_IQ;
            float sc = 0.f;
#pragma unroll
            for (int h = 0; h < 16; ++h) { const float a = wave_sum(bf1(qp[h * 64 + lane]) * bf1((bf16)f2bf(kn))); sc += F.WI[(size_t)(MP + s) * 16 + h] * fmaxf(a, 0.f); }
            if (lane == 0) F.SS[(size_t)s * SSP + PAST] = sc;
        }
    }
}

__device__ __forceinline__ void p2_phase(Frame& F) {
    REPEAT(21) { REP_BAR(); p2_sample_scores(F); REP_BAR(); }
    REPEAT(22) { REP_BAR(); p2_mlstm_a_all(F); REP_BAR(); }
    REPEAT(23) { REP_BAR(); p2_indexer<0>(F); REP_BAR(); }
}
__device__ __forceinline__ unsigned fkey(float f) { const unsigned u = __builtin_bit_cast(unsigned, f); return (u & 0x80000000u) ? ~u : (u | 0x80000000u); }
#define CNT8(c0, c1, c2, c3, u, o, cand) do { unsigned long long t0_, t1_, t2_, t3_, t4_, t5_, t6_, t7_; \
  asm volatile("v_cmp_ge_u32_e64 %4, %12, %20\n\tv_cmp_ge_u32_e64 %5, %13, %20\n\tv_cmp_ge_u32_e64 %6, %14, %20\n\tv_cmp_ge_u32_e64 %7, %15, %20\n\t" \
               "v_cmp_ge_u32_e64 %8, %16, %20\n\tv_cmp_ge_u32_e64 %9, %17, %20\n\tv_cmp_ge_u32_e64 %10, %18, %20\n\tv_cmp_ge_u32_e64 %11, %19, %20\n\t" \
               "v_addc_co_u32_e64 %0, %4, %0, 0, %4\n\tv_addc_co_u32_e64 %1, %5, %1, 0, %5\n\tv_addc_co_u32_e64 %2, %6, %2, 0, %6\n\tv_addc_co_u32_e64 %3, %7, %3, 0, %7\n\t" \
               "v_addc_co_u32_e64 %0, %8, %0, 0, %8\n\tv_addc_co_u32_e64 %1, %9, %1, 0, %9\n\tv_addc_co_u32_e64 %2, %10, %2, 0, %10\n\tv_addc_co_u32_e64 %3, %11, %3, 0, %11" \
    : "+v"(c0), "+v"(c1), "+v"(c2), "+v"(c3), "=&s"(t0_), "=&s"(t1_), "=&s"(t2_), "=&s"(t3_), "=&s"(t4_), "=&s"(t5_), "=&s"(t6_), "=&s"(t7_) \
    : "v"(u[o]), "v"(u[(o) + 1]), "v"(u[(o) + 2]), "v"(u[(o) + 3]), "v"(u[(o) + 4]), "v"(u[(o) + 5]), "v"(u[(o) + 6]), "v"(u[(o) + 7]), "s"(cand)); } while (0)
template <int J, unsigned M> __device__ __forceinline__ void bt_stage(unsigned (&A)[32]) {
#pragma unroll
    for (int k0 = 0; k0 < 16; ++k0) { const int k = (k0 & (J - 1)) | ((k0 & ~(J - 1)) << 1);
        const unsigned t = (A[k] ^ (A[k + J] >> J)) & M; A[k] ^= t; A[k + J] ^= (t << J); }
}
__device__ __forceinline__ void bt32(unsigned (&A)[32]) { bt_stage<16, 0x0000FFFFu>(A); bt_stage<8, 0x00FF00FFu>(A); bt_stage<4, 0x0F0F0F0Fu>(A); bt_stage<2, 0x33333333u>(A); bt_stage<1, 0x55555555u>(A); }
__device__ __forceinline__ void p3_select_load(Frame& F, int b, int pos, unsigned (&v)[32]) {
    const int lane = F.lane, ngl = (((pos + 128) >> 7) + 7) >> 3;
    const unsigned* src = (const unsigned*)((const unsigned short*)F.SC + (size_t)(b * SEQ + pos) * SCPH) + lane;
#pragma unroll
    for (int g = 0; g < 4; ++g) {
        if (g < ngl) {
#pragma unroll
            for (int k = 0; k < 8; ++k) v[8 * g + k] = src[64 * (8 * g + k)];
        } else {
#pragma unroll
            for (int k = 0; k < 8; ++k) v[8 * g + k] = 0u;
        }
    }
}
__device__ __forceinline__ void p3_select_put(Frame& F, int pos, const unsigned (&v)[32]) {
    const int lane = F.lane, ngl = (((pos + 128) >> 7) + 7) >> 3;
    LAS unsigned* wl = (LAS unsigned*)(F.lds + F.wave * 17408) + lane;
#pragma unroll
    for (int g = 0; g < 4; ++g) if (g < ngl) {
#pragma unroll
        for (int k = 0; k < 8; ++k) { const int i = 8 * g + k, k0 = 128 * i + 2 * lane; const unsigned x = v[i];
            const unsigned key = x ^ ((((x >> 15) & 0x00010001u) * 0xFFFFu) | 0x80008000u);
            wl[i * 68] = key & ((k0 <= pos ? 0x0000FFFFu : 0u) | (k0 + 1 <= pos ? 0xFFFF0000u : 0u)); } }
}
__device__ __forceinline__ unsigned spread16(unsigned x) { x &= 0xFFFFu; x = (x | (x << 8)) & 0x00FF00FFu; x = (x | (x << 4)) & 0x0F0F0F0Fu; x = (x | (x << 2)) & 0x33333333u; return (x | (x << 1)) & 0x55555555u; }
__device__ __forceinline__ void p3_select_row(Frame& F, int b, int pos) {
    const int lane = F.lane;
    const int n = pos + 1, nc = (n + 127) >> 7;
    unsigned* dst = F.BMT + ((size_t)(b * 128 + 2 * lane)) * BMP + pos;
    if (n <= 256) {
        const int nv = n - 64 * lane;
        const unsigned lo = nv >= 32 ? 0xFFFFFFFFu : (nv > 0 ? (1u << nv) - 1u : 0u), hi = nv >= 64 ? 0xFFFFFFFFu : (nv > 32 ? (1u << (nv - 32)) - 1u : 0u);
        dst[0] = lo; dst[BMP] = hi; return;
    }
    unsigned A[32];
    { const int ci = lane >> 1; const bool ok = ci < nc;
      const LAS v4u* rp = (const LAS v4u*)((LAS unsigned*)(F.lds + F.wave * 17408) + (ok ? ci : 0) * 68 + 32 * (lane & 1));
#pragma unroll
      for (int c = 0; c < 8; ++c) { const v4u x = rp[c];
          A[31 - 4 * c] = ok ? x.x : 0u; A[30 - 4 * c] = ok ? x.y : 0u; A[29 - 4 * c] = ok ? x.z : 0u; A[28 - 4 * c] = ok ? x.w : 0u; } }
    bt32(A);
    unsigned eq_e = 0xFFFFFFFFu, eq_o = 0xFFFFFFFFu, gt_e = 0u, gt_o = 0u; int above = 0;
#pragma unroll
    for (int bit = 15; bit >= 0; --bit) {
        const unsigned al = eq_e & A[31 - bit], ah = eq_o & A[15 - bit];
        const int tot = wave_sum_i(__builtin_popcount(al) + __builtin_popcount(ah));
        const bool take = (above + tot) >= 256;
        const unsigned x = take ? 0u : 0xFFFFFFFFu;
        gt_e |= al & x; gt_o |= ah & x;
        eq_e &= A[31 - bit] ^ x; eq_o &= A[15 - bit] ^ x;
        above += take ? 0 : tot;
    }
    const int need = 256 - above, pc = __builtin_popcount(eq_e) + __builtin_popcount(eq_o), ce = wave_sum_i(pc);
    unsigned sel_lo = spread16(gt_e | eq_e) | (spread16(gt_o | eq_o) << 1), sel_hi = spread16((gt_e | eq_e) >> 16) | (spread16((gt_o | eq_o) >> 16) << 1);
    if (ce != need) {
        int inc = pc;
#pragma unroll
        for (int o = 1; o < 64; o <<= 1) { const int t = __shfl_up(inc, o); if (lane >= o) inc += t; }
        int kt = need - (inc - pc); kt = kt < 0 ? 0 : (kt > pc ? pc : kt);
        unsigned long long e = ((unsigned long long)(spread16(eq_e >> 16) | (spread16(eq_o >> 16) << 1)) << 32) | (spread16(eq_e) | (spread16(eq_o) << 1)), s = 0ull;
        for (int i = 0; i < kt; ++i) { const unsigned long long low = e & (0ull - e); s |= low; e ^= low; }
        sel_lo = (spread16(gt_e) | (spread16(gt_o) << 1)) | (unsigned)s; sel_hi = (spread16(gt_e >> 16) | (spread16(gt_o >> 16) << 1)) | (unsigned)(s >> 32);
    }
    dst[0] = sel_lo; dst[BMP] = sel_hi;
}
__device__ __forceinline__ void p3_select(Frame& F) {
    const int skip = (F.G > 2 * MS) ? MS : 0;
    const int gw = ((int)blockIdx.x - skip) * NWAVES + F.wave, NGW = (F.G - skip) * NWAVES;
    const int nrows = (gw >= 0 && gw < MP / 2) ? 2 * ((MP / 2 - 1 - gw) / NGW + 1) : 0;
    unsigned va[32];
    if (nrows > 0) p3_select_load(F, gw >> 11, gw & 2047, va);
#pragma unroll 1
    for (int j = 0; j < nrows; ++j) {
        const int t0 = gw + (j >> 1) * NGW, b0 = t0 >> 11, p0 = (j & 1) ? SEQ - 1 - (t0 & 2047) : (t0 & 2047);
        p3_select_put(F, p0, va);
        if (j + 1 < nrows) { const int t1 = gw + ((j + 1) >> 1) * NGW; p3_select_load(F, t1 >> 11, ((j + 1) & 1) ? SEQ - 1 - (t1 & 2047) : (t1 & 2047), va); }
        p3_select_row(F, b0, p0);
    }
}
__device__ __forceinline__ void p3_scan(Frame& F) {
    const int NGT = F.G * NTHR;
    LAS float* tab = (LAS float*)F.lds;
    for (int t0 = blockIdx.x * NTHR; t0 < 8 * 16384; t0 += NGT) {
        const int bh = t0 >> 14;
        const int e4 = ((t0 & 16383) * 2) + 4 * F.tid;
        const bf16* up = (const bf16*)F.UP + (size_t)bh * 64 * 32768 + e4; bf16* cs = F.CST + (size_t)bh * 64 * 32768 + e4;
#define SCAN_LD(dst, cb_) do { _Pragma("unroll") for (int k = 0; k < 16; ++k) dst[k] = *(const GAS v2u*)(up + (size_t)((cb_) + k) * 32768); } while (0)
#define SCAN_DO(src, cb_) do { _Pragma("unroll") for (int k = 0; k < 16; ++k) { const int c = (cb_) + k; \
                    v2u o_; o_.x = cvt2(c0, c1); o_.y = cvt2(c2, c3); *(GAS v2u*)(cs + (size_t)c * 32768) = o_; \
                    const f32x2 ab = *(LAS f32x2*)(tab + 2 * c); \
                    c0 = ab.x * c0 + ab.y * bflo(src[k].x); c1 = ab.x * c1 + ab.y * bfhi(src[k].x); c2 = ab.x * c2 + ab.y * bflo(src[k].y); c3 = ab.x * c3 + ab.y * bfhi(src[k].y); } } while (0)
        v2u ua[16], ub[16];
        if (F.tid < 256) { SCAN_LD(ua, 0); SCAN_LD(ub, 16); }
        __syncthreads();
        if (F.tid < 64) { tab[128 + F.tid] = F.CHG[bh * 64 + F.tid]; tab[192 + F.tid] = F.CHG[512 + bh * 64 + F.tid]; }
        __syncthreads();
        if (F.tid == 0) { float m = 0.f;
#pragma unroll
            for (int c = 0; c < 64; ++c) { tab[256 + c] = m; m = tab[192 + c] + fmaxf(m, tab[128 + c]); } }
        __syncthreads();
        if (F.tid < 64) { const float m = tab[256 + F.tid], G = tab[128 + F.tid], M = fmaxf(m, G); tab[2 * F.tid] = __expf(m - M); tab[2 * F.tid + 1] = __expf(G - M); }
        __syncthreads();
        if (F.tid < 256) {
            float c0 = 0.f, c1 = 0.f, c2 = 0.f, c3 = 0.f;
            SCAN_DO(ua, 0); SCAN_LD(ua, 32);
            SCAN_DO(ub, 16); SCAN_LD(ub, 48);
            SCAN_DO(ua, 32); SCAN_DO(ub, 48);
            *(GAS f32x4*)(F.out + O_CP + (size_t)bh * 32768 + e4) = (f32x4){c0, c1, c2, c3};
        }
#undef SCAN_LD
#undef SCAN_DO
    }
    if ((int)blockIdx.x == ((F.G > 2 * MS) ? MS - 1 : F.G - 1)) {
        const int r = F.tid, bh2 = r >> 6, d2 = (r & 63) * 2;
        float m = 0.f, n0 = 0.f, n1 = 0.f;
        const float* gp = F.CHG + bh2 * 64;
#pragma unroll 1
        for (int cb = 0; cb < 64; cb += 16) {
            float Gs[16], Bs[16]; f32x2 un[16];
#pragma unroll
            for (int k = 0; k < 16; ++k) { Gs[k] = gp[cb + k]; Bs[k] = gp[512 + cb + k]; un[k] = *(const GAS f32x2*)(F.UN + (size_t)(bh2 * 64 + cb + k) * 128 + d2); }
#pragma unroll
            for (int k = 0; k < 16; ++k) { const int c = cb + k;
                *(GAS f32x2*)(F.NST + (size_t)(bh2 * 64 + c) * 128 + d2) = (f32x2){n0, n1};
                if (d2 == 0) F.MST[bh2 * 64 + c] = m;
                const float G = Gs[k], B = Bs[k], M = fmaxf(m, G), al = __expf(m - M), be = __expf(G - M);
                n0 = al * n0 + be * un[k].x; n1 = al * n1 + be * un[k].y; m = B + M; }
        }
        *(GAS f32x2*)(F.out + O_NP + (size_t)bh2 * 128 + d2) = (f32x2){n0, n1};
        if (d2 == 0) F.out[O_MPR + bh2] = m;
    }
    __syncthreads();
}
__device__ __forceinline__ int block_sum(Frame& F, int v, LAS int* red, int par) {
    const int w = wave_sum_i(v);
    if (F.lane == 0) red[par * 8 + F.wave] = w;
    __syncthreads();
    int s = 0;
#pragma unroll
    for (int i = 0; i < NWAVES; ++i) s += red[par * 8 + i];
    return s;
}
__device__ __forceinline__ int block_excl_scan(Frame& F, int v, LAS int* red) {
    int inc = v;
#pragma unroll
    for (int o = 1; o < 64; o <<= 1) { const int t = __shfl_up(inc, o); if (F.lane >= o) inc += t; }
    __syncthreads();
    if (F.lane == 63) red[F.wave] = inc;
    __syncthreads();
    int base = 0;
#pragma unroll
    for (int i = 0; i < NWAVES; ++i) if (i < F.wave) base += red[i];
    return base + inc - v;
}
__device__ __forceinline__ void p3_sample_select(Frame& F, int s) {
    constexpr int PER = 33;
    LAS unsigned* ul = (LAS unsigned*)F.lds;
    LAS int* red = (LAS int*)(F.lds + 16896 * 4);
    __syncthreads();
    { const GAS float* ss = (const GAS float*)(F.SS + (size_t)s * SSP);
      float sv[PER];
#pragma unroll
      for (int k = 0; k < PER; ++k) { const int i = F.tid + NTHR * k; sv[k] = ss[i < LS ? i : LS - 1]; }
#pragma unroll
      for (int k = 0; k < PER; ++k) { const int i = F.tid + NTHR * k; ul[i] = (i < LS) ? fkey(sv[k]) : 0u; } }
    __syncthreads();
    unsigned u[PER];
#pragma unroll
    for (int i = 0; i < PER; ++i) u[i] = ul[F.tid * PER + i];
    unsigned A[32];
#pragma unroll
    for (int i = 0; i < 32; ++i) A[i] = u[31 - i];
    bt32(A);
    const unsigned ux = u[32];
    unsigned eq = 0xFFFFFFFFu, thr = 0u; bool eqx = true; int above = 0;
#pragma unroll
    for (int it = 0; it < 16; ++it) {
        const int b0 = 30 - 2 * it;
        const unsigned P1 = A[2 * it], P0 = A[2 * it + 1];
        const unsigned m11 = eq & P1 & P0, m10 = eq & P1 & ~P0, m01 = eq & ~P1 & P0;
        const unsigned dx = (ux >> b0) & 3u;
        const int c11 = __builtin_popcount(m11) + ((eqx && dx == 3u) ? 1 : 0), c10 = __builtin_popcount(m10) + ((eqx && dx == 2u) ? 1 : 0), c01 = __builtin_popcount(m01) + ((eqx && dx == 1u) ? 1 : 0);
        const int w0 = wave_sum_i(c11 | (c10 << 16)), w1 = wave_sum_i(c01);
        LAS int* rp = red + (it & 1) * 16;
        if (F.lane == 0) { rp[F.wave] = w0; rp[8 + F.wave] = w1; }
        __syncthreads();
        int s0 = 0, s1 = 0;
#pragma unroll
        for (int i = 0; i < NWAVES; ++i) { s0 += rp[i]; s1 += rp[8 + i]; }
        s0 = __builtin_amdgcn_readfirstlane(s0); s1 = __builtin_amdgcn_readfirstlane(s1);
        const int S11 = s0 & 0xFFFF, S10 = s0 >> 16, S01 = s1;
        unsigned d;
        if (above + S11 >= 256) d = 3u;
        else if (above + S11 + S10 >= 256) { d = 2u; above += S11; }
        else if (above + S11 + S10 + S01 >= 256) { d = 1u; above += S11 + S10; }
        else { d = 0u; above += S11 + S10 + S01; }
        eq = d == 3u ? m11 : (d == 2u ? m10 : (d == 1u ? m01 : (eq & ~P1 & ~P0)));
        eqx = eqx && (dx == d);
        thr |= d << b0;
    }
    int cg = 0, ce = 0;
#pragma unroll
    for (int i = 0; i < PER; ++i) { cg += (u[i] > thr) ? 1 : 0; ce += (u[i] == thr) ? 1 : 0; }
    __syncthreads();
    const int need = 256 - block_sum(F, cg, red, 0);
    const int ebase = block_excl_scan(F, ce, red + 64);
    int csel = 0, er = ebase;
    unsigned long long selm = 0ull;
#pragma unroll
    for (int i = 0; i < PER; ++i) { bool sel = u[i] > thr; if (u[i] == thr) { sel = er < need; ++er; } if (sel) { selm |= 1ull << i; ++csel; } }
    int pos = block_excl_scan(F, csel, red + 96);
#pragma unroll
    for (int i = 0; i < PER; ++i) if ((selm >> i) & 1ull) { if (pos < 256) F.SIDX[s * 256 + pos] = F.tid * PER + i; ++pos; }
}
__device__ __forceinline__ void p3_phase(Frame& F) {
    REPEAT(31) { REP_BAR(); for (int s = blockIdx.x; s < MS; s += F.G) p3_sample_select(F, s); REP_BAR(); }
    if ((blockIdx.x & 1) && DUP_SUB == 0) { p3_select(F); __syncthreads(); p3_scan(F); }
    else {
    REPEAT(32) { REP_BAR(); p3_scan(F); REP_BAR(); }
    p3_select(F);
    }
}
constexpr int RPAK = 272, RPAV = 320;
constexpr int AT_MOFF = 128 * RPAK + 128 * RPAV, AT_BUF = AT_MOFF + 4096;
__device__ __forceinline__ void p4_attn_unit(Frame& F, int unit) {
    const int lane = F.lane, r = lane & 31, hh = lane >> 5, blk = (lane >> 4) & 1;
    const int qb = unit & 127, kvh = (unit >> 7) & 1, b = unit >> 8;
    const int hq = kvh * 4 + (F.wave & 3), kh = F.wave >> 2, q = 32 * qb + r;
    const int nt = (qb >> 2) + 1;
    const size_t qrow = (size_t)(b * SEQ + q);
    bf16x8 Qf[8];
#pragma unroll
    for (int s = 0; s < 8; ++s) Qf[s] = *(const GAS bf16x8*)(F.P + qrow * NPAD + C_Q + hq * 128 + 16 * s + 8 * hh);
    f32x16 O[4];
#pragma unroll
    for (int c = 0; c < 4; ++c) O[c] = zero16();
    float m = -INFINITY, l = 0.f;
    const int srow = F.tid >> 4, sc16 = F.tid & 15;
    v4u kreg[4], vreg[4]; unsigned mreg;
    const int mg16 = F.tid >> 5, mrq = F.tid & 31;
    const unsigned* mbase = F.BMT + (size_t)(b * 128 + 2 * (mg16 >> 3) + ((mg16 >> 2) & 1)) * BMP + 32 * qb + mrq;
    const int msh = 4 * ((mg16 >> 1) & 1) + 16 * (mg16 & 1), moff = AT_MOFF + ((mg16 >> 2) * 32 + mrq) * 32 + ((mg16 >> 1) & 1) * 16 + 8 * (mg16 & 1);
    const bf16* kbase = F.KVC + (size_t)((b * 2 + kvh) * SEQ) * 256 + 8 * sc16;
    const bf16* vbase = kbase + 128;
#define AT_LOAD(t) do { _Pragma("unroll") for (int i = 0; i < 4; ++i) { const size_t ro = (size_t)(128 * (t) + srow + 32 * i) * 256; kreg[i] = *(const GAS v4u*)(kbase + ro); vreg[i] = *(const GAS v4u*)(vbase + ro); } mreg = mbase[(size_t)(4 * (t)) * BMP]; } while (0)
#define AT_STORE(buf) do { _Pragma("unroll") for (int i = 0; i < 4; ++i) { *(LAS v4u*)(F.lds + (buf) * AT_BUF + (srow + 32 * i) * RPAK + 16 * sc16) = kreg[i]; \
        *(LAS v4u*)(F.lds + (buf) * AT_BUF + 128 * RPAK + (srow + 32 * i) * RPAV + 16 * sc16) = vreg[i]; } \
        { const unsigned n0_ = (mreg >> msh) & 0xFu, n1_ = (mreg >> (msh + 8)) & 0xFu; v2u mm_; mm_.x = ((n0_ * 0x00204081u) & 0x01010101u) * 0xFFu; mm_.y = ((n1_ * 0x00204081u) & 0x01010101u) * 0xFFu; \
          *(LAS v2u*)(F.lds + (buf) * AT_BUF + moff) = mm_; } } while (0)
    __syncthreads();
    AT_LOAD(0); AT_STORE(0);
    if (nt > 1) AT_LOAD(1);
    __syncthreads();
    for (int t = 0; t < nt; ++t) {
        const int buf = t & 1;
        if (t + 1 < nt) AT_STORE(buf ^ 1);
        LAS unsigned char* kl = F.lds + buf * AT_BUF + (64 * kh) * RPAK; LAS unsigned char* vl = F.lds + buf * AT_BUF + 128 * RPAK + (64 * kh) * RPAV;
        f32x16 X[2];
        {
            bf16x8 Kf[16];
#define AT_KF(i) (*(LAS bf16x8*)(kl + (32 * ((i) >> 3) + r) * RPAK + (16 * ((i) & 7) + 8 * hh) * 2))
#pragma unroll
            for (int i = 0; i < 4; ++i) Kf[i] = AT_KF(i);
            __builtin_amdgcn_sched_barrier(0);
            X[0] = zero16(); X[1] = zero16();
#pragma unroll
            for (int i = 0; i < 16; ++i) { if (i + 4 < 16) Kf[i + 4] = AT_KF(i + 4); X[i >> 3] = MFMA32(Kf[i], Qf[i & 7], X[i >> 3]); __builtin_amdgcn_sched_barrier(0); }
#undef AT_KF
        }
        __builtin_amdgcn_sched_barrier(0);
        if (t + 2 < nt) AT_LOAD(t + 2);
        LAS unsigned char* ml = F.lds + buf * AT_BUF + AT_MOFF + ((2 * kh) * 32 + r) * 32 + hh * 16;
        const v4u mk0 = *(LAS v4u*)ml, mk1 = *(LAS v4u*)(ml + 1024);
        float tmax = fmaxf(X[0][0], X[1][0]);
#pragma unroll
        for (int i = 1; i < 16; ++i) tmax = fmaxf(tmax, fmaxf(X[0][i], X[1][i]));
        tmax = xhalf_max(tmax);
        const float mn = fmaxf(m, tmax);
        const float alpha = __builtin_amdgcn_exp2f((m - mn) * ATT_C), msc = mn * ATT_C;
        m = mn;
        float ps = 0.f;
        bf16x8 Pf[2][2];
#pragma unroll
        for (int sb = 0; sb < 2; ++sb) {
            const v4u mk = sb ? mk1 : mk0;
#pragma unroll
            for (int i = 0; i < 16; ++i) X[sb][i] = __builtin_amdgcn_exp2f(__builtin_fmaf(X[sb][i], ATT_C, -msc));
#pragma unroll
            for (int s2 = 0; s2 < 2; ++s2) { v4u pk;
#pragma unroll
                for (int jj = 0; jj < 4; ++jj) { const int j = 4 * s2 + jj;
                    const unsigned mw = __builtin_amdgcn_perm(mk[j >> 1], mk[j >> 1], (j & 1) ? 0x03030202u : 0x01010000u);
                    const unsigned pw = cvt2(X[sb][2 * j], X[sb][2 * j + 1]) & mw;
                    ps = __builtin_amdgcn_fdot2_f32_bf16(__builtin_bit_cast(bf16x2_t, pw), __builtin_bit_cast(bf16x2_t, 0x3F803F80u), ps, false);
                    pk[jj] = pw; }
                Pf[sb][s2] = __builtin_bit_cast(bf16x8, pk); }
        }
        l = l * alpha + ps;
#pragma unroll
        for (int c = 0; c < 4; ++c)
#pragma unroll
            for (int i = 0; i < 16; ++i) O[c][i] *= alpha;
#pragma unroll
        for (int sb = 0; sb < 2; ++sb)
#pragma unroll
            for (int s2 = 0; s2 < 2; ++s2)
#pragma unroll
                for (int c = 0; c < 4; ++c) {
                    const bf16x8 Vf = cat8(tr_read4(vl, 32 * sb + 16 * s2 + 4 * hh, 32 * c + 16 * blk, RPAV, lane), tr_read4(vl, 32 * sb + 16 * s2 + 8 + 4 * hh, 32 * c + 16 * blk, RPAV, lane));
                    O[c] = MFMA32(Vf, Pf[sb][s2], O[c]);
                }
        __syncthreads();
    }
#undef AT_LOAD
#undef AT_STORE
    LAS float* mg = (LAS float*)F.lds + (size_t)(F.wave & 3) * 66 * 64 + lane;
    if (kh == 1) {
#pragma unroll
        for (int c = 0; c < 4; ++c)
#pragma unroll
            for (int i = 0; i < 16; ++i) mg[(16 * c + i) * 64] = O[c][i];
        mg[64 * 64] = m; mg[65 * 64] = l;
    }
    __syncthreads();
    if (kh == 0) {
        const float m1 = mg[64 * 64], l1 = mg[65 * 64];
        const float mn = fmaxf(m, m1);
        const float a0 = __builtin_amdgcn_exp2f((m - mn) * ATT_C), a1 = __builtin_amdgcn_exp2f((m1 - mn) * ATT_C);
        l = l * a0 + l1 * a1;
        l = xhalf_sum(l);
        const float inv = __builtin_amdgcn_rcpf(l);
        LAS unsigned char* ot = F.lds + AT_BUF + r * 2064 + (F.wave & 3) * 512;
#pragma unroll
        for (int c = 0; c < 4; ++c)
#pragma unroll
            for (int g = 0; g < 4; ++g) { f32x4 o;
#pragma unroll
                for (int jj = 0; jj < 4; ++jj) o[jj] = (O[c][4 * g + jj] * a0 + mg[(16 * c + 4 * g + jj) * 64] * a1) * inv;
                *(LAS f32x4*)(ot + (32 * c + 8 * g + 4 * hh) * 4) = o; }
    }
    __syncthreads();
    {
        const int ck = F.tid & 63;
        v4u az[4];
#pragma unroll
        for (int i = 0; i < 4; ++i) az[i] = *(const GAS v4u*)(F.P + (size_t)(b * SEQ + 32 * qb + (F.tid >> 6) + 8 * i) * NPAD + C_AZ + kvh * 512 + 8 * ck);
#pragma unroll
        for (int i = 0; i < 4; ++i) { const int qq = (F.tid >> 6) + 8 * i;
            const f32x4 h0 = *(LAS f32x4*)(F.lds + AT_BUF + qq * 2064 + 32 * ck), h1 = *(LAS f32x4*)(F.lds + AT_BUF + qq * 2064 + 32 * ck + 16);
            v4u o;
            o.x = cvt2(h0.x * siluf_(bflo(az[i].x)), h0.y * siluf_(bfhi(az[i].x))); o.y = cvt2(h0.z * siluf_(bflo(az[i].y)), h0.w * siluf_(bfhi(az[i].y)));
            o.z = cvt2(h1.x * siluf_(bflo(az[i].z)), h1.y * siluf_(bfhi(az[i].z))); o.w = cvt2(h1.z * siluf_(bflo(az[i].w)), h1.w * siluf_(bfhi(az[i].w)));
            *(GAS v4u*)(F.MIX + (size_t)(b * SEQ + 32 * qb + qq) * DM + kvh * 512 + 8 * ck) = o; }
    }
}

constexpr int RPQK = 272;
constexpr int MC_QOFF = 0, MC_KOFF = 64 * RPQK, MC_VOFF = 2 * 64 * RPQK  , MC_TOFF = MC_VOFF + 64 * RPV  ;
struct MlcRegs { v4u q[2]; v4u k[2]; v4u v[4]; float ig, lf, m0; };
__device__ __forceinline__ void p4_mlstm_c_load(Frame& F, int unit, MlcRegs& R) {
    const int c = unit & 63, h = (unit >> 6) & 3, b = unit >> 8, row0 = b * SEQ + 64 * c;
    R.m0 = F.MST[unit];
    if (F.wave == 0) { R.ig = F.IG[(size_t)(row0 + F.lane) * 4 + h]; R.lf = F.LF[(size_t)(row0 + F.lane) * 4 + h]; }
#pragma unroll
    for (int i = 0; i < 2; ++i) { const int ch = F.tid + 512 * i, s = ch >> 4, c16 = ch & 15;
        R.q[i] = *(const GAS v4u*)(F.P + (size_t)(row0 + s) * NPAD + C_MQ + h * 128 + 8 * c16); R.k[i] = *(const GAS v4u*)(F.P + (size_t)(row0 + s) * NPAD + C_MK + h * 128 + 8 * c16); }
#pragma unroll
    for (int i = 0; i < 4; ++i) { const int ch = F.tid + 512 * i, s = ch >> 5, c16 = ch & 31; R.v[i] = *(const GAS v4u*)(F.P + (size_t)(row0 + s) * NPAD + C_MV + h * 256 + 8 * c16); }
}
__device__ __forceinline__ void p4_mlstm_c(Frame& F, int unit, const MlcRegs& R, int next_unit, MlcRegs& Rn) {
    const int lane = F.lane, r = lane & 31, hh = lane >> 5, blk = (lane >> 4) & 1;
    const int c = unit & 63, h = (unit >> 6) & 3, b = unit >> 8;
    const int row0 = b * SEQ + 64 * c;
    LAS float* tg = (LAS float*)(F.lds + MC_TOFF); LAS float* tM = tg + 64; LAS float* ta = tg + 128; LAS float* tb = tg + 192; LAS float* tnq = tg + 256; LAS float* tss = tg + 384;
    const float m0 = R.m0;
    const int tt = F.wave & 1, vg = F.wave >> 1;
    const bf16* cst = F.CST + (size_t)unit * 32768;
    bf16x8 Cf[2][8];
#pragma unroll
    for (int ks = 0; ks < 8; ++ks) Cf[0][ks] = *(const GAS bf16x8*)(cst + (size_t)(32 * vg + r) * 128 + 16 * ks + 8 * hh);
    float nreg[16];
    { const GAS f32x4* np4 = (const GAS f32x4*)(F.NST + (size_t)unit * 128 + 16 * (F.tid >> 6));
#pragma unroll
      for (int i = 0; i < 4; ++i) { const f32x4 t4 = np4[i]; nreg[4 * i] = t4.x; nreg[4 * i + 1] = t4.y; nreg[4 * i + 2] = t4.z; nreg[4 * i + 3] = t4.w; } }
    __syncthreads();
    if (F.wave == 0) {
        float bc = R.lf;
#pragma unroll
        for (int o = 1; o < 64; o <<= 1) { const float t = __shfl_up(bc, o); if (lane >= o) bc += t; }
        const float g = R.ig - bc;
        float cm = g;
#pragma unroll
        for (int o = 1; o < 64; o <<= 1) { const float t = __shfl_up(cm, o); if (lane >= o) cm = fmaxf(cm, t); }
        const float Mt = fmaxf(m0, cm);
        tg[lane] = g; tM[lane] = Mt; ta[lane] = __expf(m0 - Mt); tb[lane] = bc;
    }
#pragma unroll
    for (int i = 0; i < 2; ++i) { const int ch = F.tid + 512 * i, s = ch >> 4, c16 = ch & 15;
        *(LAS v4u*)(F.lds + MC_QOFF + s * RPQK + 16 * c16) = R.q[i]; *(LAS v4u*)(F.lds + MC_KOFF + s * RPQK + 16 * c16) = R.k[i]; }
#pragma unroll
    for (int i = 0; i < 4; ++i) { const int ch = F.tid + 512 * i, s = ch >> 5, c16 = ch & 31;
        *(LAS v4u*)(F.lds + MC_VOFF + s * RPV + 16 * c16) = R.v[i]; }
    if (next_unit >= 0) p4_mlstm_c_load(F, next_unit, Rn);
    __syncthreads();
    { const int t = F.tid & 63, dq = F.tid >> 6; float a = 0.f;
#pragma unroll
      for (int d = 0; d < 16; ++d) a += nreg[d] * bf1(*(LAS bf16*)(F.lds + MC_QOFF + t * RPQK + (16 * dq + d) * 2));
      tss[dq * 64 + t] = a; }
    __syncthreads();
    if (F.tid < 64) { float a = 0.f;
#pragma unroll
        for (int i = 0; i < 8; ++i) a += tss[i * 64 + F.tid];
        tnq[F.tid] = a; }
    const int tcol = 32 * tt + r;
    const float Mt = tM[tcol], at = ta[tcol];
    bf16x8 Sf[2][2];
    float colsum = 0.f;
#pragma unroll
    for (int st = 0; st < 2; ++st) {
        f32x16 X = zero16();
        if (st <= tt) {
#pragma unroll
            for (int ks = 0; ks < 8; ++ks) X = MFMA32(*(LAS bf16x8*)(F.lds + MC_KOFF + (32 * st + r) * RPQK + (16 * ks + 8 * hh) * 2), *(LAS bf16x8*)(F.lds + MC_QOFF + tcol * RPQK + (16 * ks + 8 * hh) * 2), X);
#pragma unroll
            for (int i = 0; i < 16; ++i) { const int s = 32 * st + (i & 3) + 8 * (i >> 2) + 4 * hh;
                const float dv = (s <= tcol) ? __expf(tg[s] - Mt) : 0.f; X[i] *= dv; colsum += X[i]; }
        }
#pragma unroll
        for (int s2 = 0; s2 < 2; ++s2) { v4u pk; pk.x = cvt2(X[8 * s2], X[8 * s2 + 1]); pk.y = cvt2(X[8 * s2 + 2], X[8 * s2 + 3]); pk.z = cvt2(X[8 * s2 + 4], X[8 * s2 + 5]); pk.w = cvt2(X[8 * s2 + 6], X[8 * s2 + 7]);
            Sf[st][s2] = __builtin_bit_cast(bf16x8, pk); }
    }
    colsum = xhalf_sum(colsum);
    __syncthreads();
    const float den = at * tnq[tcol] + colsum;
    const float mt_abs = tb[tcol] + Mt;
    const float dn = 1.f / fmaxf(fabsf(den), __expf(-mt_abs));
    bf16x8 Qs[8];
#pragma unroll
    for (int ks = 0; ks < 8; ++ks) { const v4u qv = *(LAS v4u*)(F.lds + MC_QOFF + tcol * RPQK + (16 * ks + 8 * hh) * 2);
        v4u o; o.x = cvt2(bflo(qv.x) * at, bfhi(qv.x) * at); o.y = cvt2(bflo(qv.y) * at, bfhi(qv.y) * at); o.z = cvt2(bflo(qv.z) * at, bfhi(qv.z) * at); o.w = cvt2(bflo(qv.w) * at, bfhi(qv.w) * at);
        Qs[ks] = __builtin_bit_cast(bf16x8, o); }
    f32x16 H[2]; float ssq = 0.f;
#pragma unroll
    for (int ks = 0; ks < 8; ++ks) Cf[1][ks] = *(const GAS bf16x8*)(cst + (size_t)(32 * (vg + 4) + r) * 128 + 16 * ks + 8 * hh);
#pragma unroll
    for (int vi = 0; vi < 2; ++vi) {
        const int vt = vg + 4 * vi;
        f32x16 acc = zero16();
#pragma unroll
        for (int ks = 0; ks < 8; ++ks) acc = MFMA32(Cf[vi][ks], Qs[ks], acc);
#pragma unroll
        for (int st = 0; st < 2; ++st) if (st <= tt) {
#pragma unroll
            for (int s2 = 0; s2 < 2; ++s2) {
                const bf16x8 Vf = cat8(tr_read4(F.lds + MC_VOFF, 32 * st + 16 * s2 + 4 * hh, 32 * vt + 16 * blk, RPV, lane), tr_read4(F.lds + MC_VOFF, 32 * st + 16 * s2 + 8 + 4 * hh, 32 * vt + 16 * blk, RPV, lane));
                acc = MFMA32(Vf, Sf[st][s2], acc);
            }
        }
#pragma unroll
        for (int i = 0; i < 16; ++i) { acc[i] *= dn; ssq += acc[i] * acc[i]; }
        H[vi] = acc;
    }
    ssq = xhalf_sum(ssq);
    if (hh == 0) tss[F.wave * 32 + r] = ssq;
    __syncthreads();
    float tot = 0.f;
#pragma unroll
    for (int w2 = 0; w2 < 4; ++w2) tot += tss[(2 * w2 + tt) * 32 + r];
    const float rs = 1.f / sqrtf(tot * (1.f / 256.f) + RMS_EPS);
    const size_t trow = (size_t)(row0 + tcol);
    const bf16* mop = F.P + trow * NPAD + C_MO + h * 256; const bf16* mzp = F.P + trow * NPAD + C_MZ + h * 256; bf16* mp = F.MIX + trow * DM + 1024 + h * 256;
    const float* nw = F.ml_norm_w + h * 256;
#pragma unroll
    for (int vi = 0; vi < 2; ++vi)
#pragma unroll
        for (int g = 0; g < 4; ++g) { const int v = 32 * (vg + 4 * vi) + 8 * g + 4 * hh;
            const v2u mo = *(const GAS v2u*)(mop + v), mz = *(const GAS v2u*)(mzp + v); const f32x4 w4 = *(const GAS f32x4*)(nw + v);
            const float o0 = H[vi][4 * g] * rs * w4.x * sigmoidf_(bflo(mo.x)) * siluf_(bflo(mz.x)), o1 = H[vi][4 * g + 1] * rs * w4.y * sigmoidf_(bfhi(mo.x)) * siluf_(bfhi(mz.x));
            const float o2 = H[vi][4 * g + 2] * rs * w4.z * sigmoidf_(bflo(mo.y)) * siluf_(bflo(mz.y)), o3 = H[vi][4 * g + 3] * rs * w4.w * sigmoidf_(bfhi(mo.y)) * siluf_(bfhi(mz.y));
            v2u o; o.x = cvt2(o0, o1); o.y = cvt2(o2, o3); *(GAS v2u*)(mp + v) = o; }
}

constexpr int MC_HALF = MC_TOFF + 2304;
__device__ __forceinline__ void p4_mlstm_c2(Frame& F, int unitA, int unitB) {
    const int lane = F.lane, r = lane & 31, hh = lane >> 5, blk = (lane >> 4) & 1;
    const int half = F.wave >> 2, hw = F.wave & 3, htid = F.tid & 255;
    const int unit = half ? unitB : unitA; const bool act = unit >= 0;
    const int uu = act ? unit : 0;
    const int c = uu & 63, h = (uu >> 6) & 3, b = uu >> 8, row0 = b * SEQ + 64 * c;
    LAS unsigned char* LB = F.lds + half * MC_HALF;
    LAS float* tg = (LAS float*)(LB + MC_TOFF); LAS float* tM = tg + 64; LAS float* ta = tg + 128; LAS float* tb = tg + 192; LAS float* tnq = tg + 256; LAS float* tss = tg + 320;
    const int tt = hw & 1, vg = hw >> 1, tcol = 32 * tt + r;
    const bf16* cst = F.CST + (size_t)uu * 32768;
    const float m0 = F.MST[uu];
    float ig = 0.f, lf = 0.f;
    if (hw == 0) { ig = F.IG[(size_t)(row0 + lane) * 4 + h]; lf = F.LF[(size_t)(row0 + lane) * 4 + h]; }
    v4u qr[4], kr[4], vr[8];
#pragma unroll
    for (int i = 0; i < 4; ++i) { const int ch = htid + 256 * i, s = ch >> 4, c16 = ch & 15;
        qr[i] = *(const GAS v4u*)(F.P + (size_t)(row0 + s) * NPAD + C_MQ + h * 128 + 8 * c16); kr[i] = *(const GAS v4u*)(F.P + (size_t)(row0 + s) * NPAD + C_MK + h * 128 + 8 * c16); }
#pragma unroll
    for (int i = 0; i < 8; ++i) { const int ch = htid + 256 * i, s = ch >> 5, c16 = ch & 31; vr[i] = *(const GAS v4u*)(F.P + (size_t)(row0 + s) * NPAD + C_MV + h * 256 + 8 * c16); }
    float nreg[32];
    { const GAS f32x4* np4 = (const GAS f32x4*)(F.NST + (size_t)uu * 128 + 32 * (htid >> 6));
#pragma unroll
      for (int i = 0; i < 8; ++i) { const f32x4 t4 = np4[i]; nreg[4 * i] = t4.x; nreg[4 * i + 1] = t4.y; nreg[4 * i + 2] = t4.z; nreg[4 * i + 3] = t4.w; } }
    __syncthreads();
    if (hw == 0) {
        float bc = lf;
#pragma unroll
        for (int o = 1; o < 64; o <<= 1) { const float t = __shfl_up(bc, o); if (lane >= o) bc += t; }
        const float g = ig - bc;
        float cm = g;
#pragma unroll
        for (int o = 1; o < 64; o <<= 1) { const float t = __shfl_up(cm, o); if (lane >= o) cm = fmaxf(cm, t); }
        const float Mt_ = fmaxf(m0, cm);
        tg[lane] = g; tM[lane] = Mt_; ta[lane] = __expf(m0 - Mt_); tb[lane] = bc;
    }
#pragma unroll
    for (int i = 0; i < 4; ++i) { const int ch = htid + 256 * i, s = ch >> 4, c16 = ch & 15;
        *(LAS v4u*)(LB + MC_QOFF + s * RPQK + 16 * c16) = qr[i]; *(LAS v4u*)(LB + MC_KOFF + s * RPQK + 16 * c16) = kr[i]; }
#pragma unroll
    for (int i = 0; i < 8; ++i) { const int ch = htid + 256 * i, s = ch >> 5, c16 = ch & 31; *(LAS v4u*)(LB + MC_VOFF + s * RPV + 16 * c16) = vr[i]; }
    bf16x8 Cf[2][8];
#pragma unroll
    for (int ks = 0; ks < 8; ++ks) Cf[0][ks] = *(const GAS bf16x8*)(cst + (size_t)(32 * vg + r) * 128 + 16 * ks + 8 * hh);
    __syncthreads();
    { const int t = htid & 63, dq = htid >> 6; float a = 0.f;
#pragma unroll
      for (int d = 0; d < 32; ++d) a += nreg[d] * bf1(*(LAS bf16*)(LB + MC_QOFF + t * RPQK + (32 * dq + d) * 2));
      tss[dq * 64 + t] = a; }
    __syncthreads();
    if (htid < 64) tnq[htid] = (tss[htid] + tss[64 + htid]) + (tss[128 + htid] + tss[192 + htid]);
    const float Mt = tM[tcol], at = ta[tcol];
    bf16x8 Sf[2][2];
    float colsum = 0.f;
#pragma unroll
    for (int st = 0; st < 2; ++st) {
        f32x16 X = zero16();
        if (st <= tt) {
#pragma unroll
            for (int ks = 0; ks < 8; ++ks) X = MFMA32(*(LAS bf16x8*)(LB + MC_KOFF + (32 * st + r) * RPQK + (16 * ks + 8 * hh) * 2), *(LAS bf16x8*)(LB + MC_QOFF + tcol * RPQK + (16 * ks + 8 * hh) * 2), X);
#pragma unroll
            for (int i = 0; i < 16; ++i) { const int so = 32 * st + (i & 3) + 8 * (i >> 2);
                const float e = __expf((tg + 4 * hh)[so] - Mt); const float dv = (so + 4 * hh <= tcol) ? e : 0.f; X[i] *= dv; colsum += X[i]; }
        }
#pragma unroll
        for (int s2 = 0; s2 < 2; ++s2) { v4u pk; pk.x = cvt2(X[8 * s2], X[8 * s2 + 1]); pk.y = cvt2(X[8 * s2 + 2], X[8 * s2 + 3]); pk.z = cvt2(X[8 * s2 + 4], X[8 * s2 + 5]); pk.w = cvt2(X[8 * s2 + 6], X[8 * s2 + 7]);
            Sf[st][s2] = __builtin_bit_cast(bf16x8, pk); }
    }
    colsum = xhalf_sum(colsum);
    __syncthreads();
    const float den = at * tnq[tcol] + colsum;
    const float dn = 1.f / fmaxf(fabsf(den), __expf(-(tb[tcol] + Mt)));
    bf16x8 Qs[8];
#pragma unroll
    for (int ks = 0; ks < 8; ++ks) { const v4u qv = *(LAS v4u*)(LB + MC_QOFF + tcol * RPQK + (16 * ks + 8 * hh) * 2);
        v4u o; o.x = cvt2(bflo(qv.x) * at, bfhi(qv.x) * at); o.y = cvt2(bflo(qv.y) * at, bfhi(qv.y) * at); o.z = cvt2(bflo(qv.z) * at, bfhi(qv.z) * at); o.w = cvt2(bflo(qv.w) * at, bfhi(qv.w) * at);
        Qs[ks] = __builtin_bit_cast(bf16x8, o); }
    f32x16 H[4]; float ssq = 0.f;
#pragma unroll
    for (int vi = 0; vi < 4; ++vi) {
        const int vt = vg + 2 * vi;
        if (vi < 3) {
#pragma unroll
            for (int ks = 0; ks < 8; ++ks) Cf[(vi + 1) & 1][ks] = *(const GAS bf16x8*)(cst + (size_t)(32 * (vt + 2) + r) * 128 + 16 * ks + 8 * hh); }
        f32x16 acc = zero16();
#pragma unroll
        for (int ks = 0; ks < 8; ++ks) acc = MFMA32(Cf[vi & 1][ks], Qs[ks], acc);
#pragma unroll
        for (int st = 0; st < 2; ++st) if (st <= tt) {
#pragma unroll
            for (int s2 = 0; s2 < 2; ++s2) {
                const bf16x8 Vf = cat8(tr_read4(LB + MC_VOFF, 32 * st + 16 * s2 + 4 * hh, 32 * vt + 16 * blk, RPV, lane), tr_read4(LB + MC_VOFF, 32 * st + 16 * s2 + 8 + 4 * hh, 32 * vt + 16 * blk, RPV, lane));
                acc = MFMA32(Vf, Sf[st][s2], acc);
            }
        }
#pragma unroll
        for (int i = 0; i < 16; ++i) { acc[i] *= dn; ssq += acc[i] * acc[i]; }
        H[vi] = acc;
    }
    ssq = xhalf_sum(ssq);
    if (hh == 0) tss[hw * 32 + r] = ssq;
    __syncthreads();
    const float rs = 1.f / sqrtf((tss[tt * 32 + r] + tss[(tt + 2) * 32 + r]) * (1.f / 256.f) + RMS_EPS);
#pragma unroll
    for (int vi = 0; vi < 4; ++vi)
#pragma unroll
        for (int g = 0; g < 4; ++g) *(LAS f32x4*)(LB + tcol * 1040 + (32 * (vg + 2 * vi) + 8 * g + 4 * hh) * 4) = (f32x4){H[vi][4 * g] * rs, H[vi][4 * g + 1] * rs, H[vi][4 * g + 2] * rs, H[vi][4 * g + 3] * rs};
    __syncthreads();
    if (act) {
        const int ck = htid & 31;
        const float* nw = F.ml_norm_w + h * 256 + 8 * ck;
        const f32x4 w0 = *(const GAS f32x4*)nw, w1 = *(const GAS f32x4*)(nw + 4);
#pragma unroll 1
        for (int ib = 0; ib < 8; ib += 4) {
        v4u mo[4], mz[4];
#pragma unroll
        for (int i = 0; i < 4; ++i) { const size_t trow = (size_t)(row0 + (htid >> 5) + 8 * (ib + i));
            mo[i] = *(const GAS v4u*)(F.P + trow * NPAD + C_MO + h * 256 + 8 * ck); mz[i] = *(const GAS v4u*)(F.P + trow * NPAD + C_MZ + h * 256 + 8 * ck); }
#pragma unroll
        for (int i = 0; i < 4; ++i) { const int t = (htid >> 5) + 8 * (ib + i);
            const f32x4 h0 = *(LAS f32x4*)(LB + t * 1040 + 32 * ck), h1 = *(LAS f32x4*)(LB + t * 1040 + 32 * ck + 16);
            v4u o;
            o.x = cvt2(h0.x * w0.x * sigmoidf_(bflo(mo[i].x)) * siluf_(bflo(mz[i].x)), h0.y * w0.y * sigmoidf_(bfhi(mo[i].x)) * siluf_(bfhi(mz[i].x)));
            o.y = cvt2(h0.z * w0.z * sigmoidf_(bflo(mo[i].y)) * siluf_(bflo(mz[i].y)), h0.w * w0.w * sigmoidf_(bfhi(mo[i].y)) * siluf_(bfhi(mz[i].y)));
            o.z = cvt2(h1.x * w1.x * sigmoidf_(bflo(mo[i].z)) * siluf_(bflo(mz[i].z)), h1.y * w1.y * sigmoidf_(bfhi(mo[i].z)) * siluf_(bfhi(mz[i].z)));
            o.w = cvt2(h1.z * w1.z * sigmoidf_(bflo(mo[i].w)) * siluf_(bflo(mz[i].w)), h1.w * w1.w * sigmoidf_(bfhi(mo[i].w)) * siluf_(bfhi(mz[i].w)));
            *(GAS v4u*)(F.MIX + (size_t)(row0 + t) * DM + 1024 + h * 256 + 8 * ck) = o; }
        }
    }
}
__device__ __forceinline__ void p4_sample_attn(Frame& F, int s) {
    const int lane = F.lane, w = F.wave, kvh = w >> 2, ck = w & 3;
    LAS float* ql = (LAS float*)F.lds;
    LAS int* il = (LAS int*)(F.lds + 4096);
    LAS float* pl = (LAS float*)(F.lds + 5120);
    LAS float* st = (LAS float*)(F.lds + 13312);
    LAS float* ob = (LAS float*)(F.lds + 14336);
    __syncthreads();
    if (F.tid < 256) { const int idx = F.SIDX[s * 256 + F.tid]; il[F.tid] = (idx < PAST) ? F.page_table[s * NPAGES + (idx >> 7)] * PAGE + (idx & 127) : -1; }
    { const unsigned wq = *(const GAS unsigned*)(F.P + (size_t)(MP + s) * NPAD + C_Q + 2 * F.tid); ql[2 * F.tid] = bflo(wq); ql[2 * F.tid + 1] = bfhi(wq); }
    __syncthreads();
    {
        const int k16 = lane >> 2, p4 = lane & 3;
        float lgk[4][4];
#pragma unroll 1
        for (int ps_ = 0; ps_ < 4; ++ps_) {
            const int ro = il[64 * ck + 16 * ps_ + k16];
            const float* kr = ((ro >= 0) ? F.cache_k + ((size_t)ro * 2 + kvh) * 128 : F.out + O_KS + (size_t)s * 256 + kvh * 128) + 4 * p4;
            f32x4 kv[8];
#pragma unroll
            for (int i = 0; i < 8; ++i) kv[i] = *(const GAS f32x4*)(kr + 16 * i);
            float a[4] = {0.f, 0.f, 0.f, 0.f};
#pragma unroll
            for (int i = 0; i < 8; ++i)
#pragma unroll
                for (int g = 0; g < 4; ++g) { const f32x4 qv = *(LAS f32x4*)(ql + (4 * kvh + g) * 128 + 16 * i + 4 * p4); a[g] += kv[i].x * qv.x + kv[i].y * qv.y + kv[i].z * qv.z + kv[i].w * qv.w; }
#pragma unroll
            for (int g = 0; g < 4; ++g) { float t = a[g]; t += __shfl_xor(t, 1); t += __shfl_xor(t, 2); if (ps_ == 0) lgk[0][g] = t; else if (ps_ == 1) lgk[1][g] = t; else if (ps_ == 2) lgk[2][g] = t; else lgk[3][g] = t; }
        }
#pragma unroll
        for (int g = 0; g < 4; ++g) {
            float mx = -INFINITY;
#pragma unroll
            for (int ps_ = 0; ps_ < 4; ++ps_) { lgk[ps_][g] *= ATT_C; mx = fmaxf(mx, lgk[ps_][g]); }
            mx = wave_max(mx);
            float sm = 0.f;
#pragma unroll
            for (int ps_ = 0; ps_ < 4; ++ps_) { const float pv = __builtin_amdgcn_exp2f(lgk[ps_][g] - mx); sm += pv; if (p4 == 0) pl[(4 * kvh + g) * 256 + 64 * ck + 16 * ps_ + k16] = pv; }
            sm = wave_sum(sm) * 0.25f;
            if (lane == 0) { st[(w * 4 + g) * 2] = mx; st[(w * 4 + g) * 2 + 1] = sm; }
        }
    }
    LDS_WAIT(); asm volatile("" ::: "memory");
    {
        float o[4][2] = {{0.f, 0.f}, {0.f, 0.f}, {0.f, 0.f}, {0.f, 0.f}};
#pragma unroll 1
        for (int jb = 0; jb < 64; jb += 16) {
            f32x2 vv[16];
#pragma unroll
            for (int k = 0; k < 16; ++k) { const int ro = il[64 * ck + jb + k];
                const float* vr = (ro >= 0) ? F.cache_v + ((size_t)ro * 2 + kvh) * 128 : F.out + O_VS + (size_t)s * 256 + kvh * 128;
                vv[k] = *(const GAS f32x2*)(vr + 2 * lane); }
#pragma unroll
            for (int k = 0; k < 16; ++k)
#pragma unroll
                for (int g = 0; g < 4; ++g) { const float p = pl[(4 * kvh + g) * 256 + 64 * ck + jb + k]; o[g][0] += p * vv[k].x; o[g][1] += p * vv[k].y; }
        }
#pragma unroll
        for (int g = 0; g < 4; ++g) *(LAS f32x2*)(ob + (w * 4 + g) * 128 + 2 * lane) = (f32x2){o[g][0], o[g][1]};
    }
    __syncthreads();
    {
        const int hq = F.tid >> 6, kv2 = hq >> 2, g = hq & 3, d = 2 * (F.tid & 63);
        float M = -INFINITY;
#pragma unroll
        for (int c = 0; c < 4; ++c) M = fmaxf(M, st[((4 * kv2 + c) * 4 + g) * 2]);
        float L = 0.f, o0 = 0.f, o1 = 0.f;
#pragma unroll
        for (int c = 0; c < 4; ++c) { const int ww = 4 * kv2 + c; const float sc = __builtin_amdgcn_exp2f(st[(ww * 4 + g) * 2] - M); L += st[(ww * 4 + g) * 2 + 1] * sc;
            const f32x2 ov = *(LAS f32x2*)(ob + (ww * 4 + g) * 128 + d); o0 += ov.x * sc; o1 += ov.y * sc; }
        const float inv = 1.f / L;
        const unsigned az = *(const GAS unsigned*)(F.P + (size_t)(MP + s) * NPAD + C_AZ + hq * 128 + d);
        *(GAS unsigned*)(F.MIX + (size_t)(MP + s) * DM + hq * 128 + d) = cvt2(o0 * inv * siluf_(bflo(az)), o1 * inv * siluf_(bfhi(az)));
    }
}
__device__ __forceinline__ void p4_sample_mlstm(Frame& F, int s, int h) {
    const int lane = F.lane, tid = F.tid;
    LAS float* ql = (LAS float*)F.lds; LAS float* kl = ql + 128; LAS float* vl = ql + 256; LAS float* hl = ql + 512; LAS float* red = ql + 768;
    const size_t row = (size_t)(MP + s);
    __syncthreads();
    if (tid < 128) { ql[tid] = bf1(F.P[row * NPAD + C_MQ + h * 128 + tid]); kl[tid] = bf1(F.P[row * NPAD + C_MK + h * 128 + tid]); }
    if (tid < 256) vl[tid] = bf1(F.P[row * NPAD + C_MV + h * 256 + tid]);
    __syncthreads();
    const float ig = F.IG[row * 4 + h], lf = F.LF[row * 4 + h], m = F.state_m[s * 4 + h];
    const float mt = fmaxf(lf + m, ig), dd = __expf(ig - mt), a = __expf(lf + m - mt);
    const float* np = F.state_n + (size_t)(s * 4 + h) * 128;
    const float qk = wave_sum(ql[lane] * kl[lane] + ql[lane + 64] * kl[lane + 64]);
    const float nq = wave_sum(np[lane] * ql[lane] + np[lane + 64] * ql[lane + 64]);
    const float sv = qk * dd, den = a * nq + sv, dn = 1.f / fmaxf(fabsf(den), __expf(-mt));
    const int hw = tid >> 5, l32 = tid & 31;
    const float* Cp = F.state_C + (size_t)(s * 4 + h) * 32768; float* Co = F.out + O_CS + (size_t)(s * 4 + h) * 32768;
    const f32x4 q4 = *(LAS f32x4*)(ql + 4 * l32), k4 = *(LAS f32x4*)(kl + 4 * l32);
    f32x4 cr[16];
#pragma unroll
    for (int it = 0; it < 16; ++it) cr[it] = __builtin_nontemporal_load((const GAS f32x4*)(Cp + (size_t)(hw + 16 * it) * 128 + 4 * l32));
#pragma unroll
    for (int it = 0; it < 16; ++it) {
        const int v = hw + 16 * it;
        const f32x4 c4 = cr[it];
        float dot = c4.x * q4.x + c4.y * q4.y + c4.z * q4.z + c4.w * q4.w;
#pragma unroll
        for (int o = 1; o < 32; o <<= 1) dot += __shfl_xor(dot, o);
        const float vv = vl[v], dv = dd * vv;
        *(GAS f32x4*)(Co + (size_t)v * 128 + 4 * l32) = (f32x4){a * c4.x + dv * k4.x, a * c4.y + dv * k4.y, a * c4.z + dv * k4.z, a * c4.w + dv * k4.w};
        if (l32 == 0) hl[v] = (a * dot + sv * vv) * dn;
    }
    if (tid < 128) F.out[O_NS + (size_t)(s * 4 + h) * 128 + tid] = a * np[tid] + dd * kl[tid];
    if (tid == 0) F.out[O_MSS + s * 4 + h] = mt;
    __syncthreads();
    float hv = (tid < 256) ? hl[tid] : 0.f;
    const float w2 = wave_sum(hv * hv);
    if (lane == 0) red[F.wave] = w2;
    __syncthreads();
    float tot = 0.f;
#pragma unroll
    for (int i = 0; i < NWAVES; ++i) tot += red[i];
    const float rs = 1.f / sqrtf(tot * (1.f / 256.f) + RMS_EPS);
    if (tid < 256) {
        const float mo = bf1(F.P[row * NPAD + C_MO + h * 256 + tid]), mz = bf1(F.P[row * NPAD + C_MZ + h * 256 + tid]);
        F.MIX[row * DM + 1024 + h * 256 + tid] = (bf16)f2bf(hv * rs * F.ml_norm_w[h * 256 + tid] * sigmoidf_(mo) * siluf_(mz));
    }
}
__device__ __forceinline__ void p4_phase(Frame& F) {
    const int j = blockIdx.x;
    if (F.G == 256) {
        REPEAT(41) { REP_BAR(); if (j >= 224) p4_sample_attn(F, 255 - j); else if (j >= 96) p4_sample_mlstm(F, (223 - j) >> 2, (223 - j) & 3); REP_BAR(); }
        const bool mfirst = ((j >> 3) & 1) && DUP_SUB == 0;
        if (mfirst) { __syncthreads(); p4_mlstm_c2(F, j, j + 256); __syncthreads(); }
        for (int uu_ = 0, nu_ = (DUP_SUB == 42) ? 2 * F.two : 2; uu_ < nu_; ++uu_) { if (DUP_SUB == 42 && (uu_ & 1) == 0) xcd_barrier(*F.bar); p4_attn_unit(F, (j & 3) * 128 + ((uu_ & 1) ? (j >> 2) : 127 - (j >> 2))); }
        if (DUP_SUB == 42) xcd_barrier(*F.bar);
        if (!mfirst) {
        REPEAT(43) { REP_BAR(); p4_mlstm_c2(F, j, j + 256); REP_BAR(); }
        }
    } else {
        for (int s = j; s < MS; s += F.G) p4_sample_attn(F, s);
        for (int t = j; t < MS * 4; t += F.G) p4_sample_mlstm(F, t >> 2, t & 3);
        for (int u = j; u < 512; u += F.G) p4_attn_unit(F, u);
        for (int u = j; u < 512; u += 2 * F.G) p4_mlstm_c2(F, u, (u + F.G < 512) ? u + F.G : -1);
    }
}

struct EpiOut {
    static constexpr bool PERM = false, AFTER_DRAIN = false;
    const float* x; float* y;
    __device__ __forceinline__ void operator()(const pg8::f32x4 (&acc)[2][2][4][2], const pg8::Unit& u, int wr, int wc, int fr, int fq) const {
        const int row0 = u.pm * 256 + wr * 64 + fr, col0 = u.pn * 256 + wc * 32 + 4 * fq;
#pragma unroll
        for (int ai = 0; ai < 2; ++ai)
#pragma unroll
            for (int m = 0; m < 4; ++m) { const size_t o = (size_t)(row0 + ai * 128 + m * 16) * DM + col0;
#pragma unroll
                for (int bj = 0; bj < 2; ++bj)
#pragma unroll
                    for (int n = 0; n < 2; ++n) *(f32x4*)(y + o + bj * 128 + n * 16) = acc[ai][bj][m][n] + *(const f32x4*)(x + o + bj * 128 + n * 16); }
    }
};
__device__ __forceinline__ void p5_sample_out(Frame& F, int j) {
    const int lane = F.lane, r = lane & 31, hh = lane >> 5, w = F.wave;
    f32x16 acc = zero16();
    const bf16* ap = F.MIX + (size_t)(MP + r) * DM + 256 * w + 8 * hh; const bf16* bp = F.WOUTT + (size_t)(32 * j + r) * DM + 256 * w + 8 * hh;
    bf16x8 af[16], bfr[16];
#pragma unroll
    for (int ks = 0; ks < 16; ++ks) { af[ks] = *(const GAS bf16x8*)(ap + 16 * ks); bfr[ks] = *(const GAS bf16x8*)(bp + 16 * ks); }
    asm volatile("" ::: "memory"); __builtin_amdgcn_sched_barrier(0);
#pragma unroll
    for (int ks = 0; ks < 16; ++ks) acc = MFMA32(af[ks], bfr[ks], acc);
    LAS float* pl = (LAS float*)F.lds;
    __syncthreads();
#pragma unroll
    for (int i = 0; i < 16; ++i) pl[(w * 32 + (i & 3) + 8 * (i >> 2) + 4 * hh) * 33 + r] = acc[i];
    __syncthreads();
    const int row = F.tid >> 4, c2 = (F.tid & 15) * 2;
    float s0 = 0.f, s1 = 0.f;
#pragma unroll
    for (int ww = 0; ww < NWAVES; ++ww) { s0 += pl[(ww * 32 + row) * 33 + c2]; s1 += pl[(ww * 32 + row) * 33 + c2 + 1]; }
    const f32x2 xs = *(const GAS f32x2*)(F.x_sample + (size_t)row * DM + 32 * j + c2);
    *(GAS f32x2*)(F.out + O_YS + (size_t)row * DM + 32 * j + c2) = (f32x2){s0 + xs.x, s1 + xs.y};
    __syncthreads();
}
struct EpiOutF {
    static constexpr bool PERM = false, AFTER_DRAIN = true;
    const float* x; float* y; const float* fw; float* xch; unsigned* cnt;
    __device__ __forceinline__ void fused(pg8::f32x4 (&acc)[2][2][4][2], const pg8::Unit& u, int wr, int wc, int fr, int fq, PG8_LAS unsigned char* lds, int wid, int lane) const {
        const int col0 = u.pn * 256 + wc * 32 + 4 * fq, tid = wid * 64 + lane;
        LAS float* T = (LAS float*)lds; LAS float* R = (LAS float*)(lds + 4096);
#pragma unroll
        for (int ai = 0; ai < 2; ++ai) {
            f32x4 xv[4][2][2];
#pragma unroll
            for (int m = 0; m < 4; ++m) { const size_t off = (size_t)(u.pm * 256 + ai * 128 + wr * 64 + m * 16 + fr) * DM + col0;
#pragma unroll
                for (int bj = 0; bj < 2; ++bj)
#pragma unroll
                    for (int n = 0; n < 2; ++n) xv[m][bj][n] = __builtin_nontemporal_load((const f32x4*)(x + off + bj * 128 + n * 16)); }
#pragma unroll
            for (int m = 0; m < 4; ++m) { const int row = ai * 128 + wr * 64 + m * 16 + fr;
                float s = 0.f;
#pragma unroll
                for (int bj = 0; bj < 2; ++bj)
#pragma unroll
                    for (int n = 0; n < 2; ++n) { const f32x4 v = acc[ai][bj][m][n] + xv[m][bj][n]; acc[ai][bj][m][n] = v; s += (v[0] * v[0] + v[1] * v[1]) + (v[2] * v[2] + v[3] * v[3]); }
                s += __shfl_xor(s, 16); s += __shfl_xor(s, 32);
                if (fq == 0) T[row * 4 + wc] = s; }
        }
        __syncthreads();
        float* slot = xch + (size_t)(u.pm * 8) * 256 + tid;
        if (tid < 256) { const f32x4 t4 = *(LAS f32x4*)(T + tid * 4); __hip_atomic_store(slot + u.pn * 256, (t4[0] + t4[1]) + (t4[2] + t4[3]), __ATOMIC_RELAXED, __HIP_MEMORY_SCOPE_AGENT); }
        asm volatile("s_waitcnt vmcnt(0)" ::: "memory");
        __syncthreads();
        if (tid == 0) {
            unsigned* c = cnt + 64 * u.pm;
            __hip_atomic_fetch_add(c, 1u, __ATOMIC_RELAXED, __HIP_MEMORY_SCOPE_AGENT);
            unsigned sp = 0;
            while (__hip_atomic_load(c, __ATOMIC_RELAXED, __HIP_MEMORY_SCOPE_AGENT) < 8u) { __builtin_amdgcn_s_sleep(1); if (++sp > (1u << 18)) break; }
        }
        __syncthreads();
        if (tid < 256) { float tot = 0.f;
#pragma unroll
            for (int pn = 0; pn < 8; ++pn) tot += __hip_atomic_load(slot + pn * 256, __ATOMIC_RELAXED, __HIP_MEMORY_SCOPE_AGENT);
            R[tid] = 1.f / sqrtf(tot * (1.f / DM) + RMS_EPS); }
        __syncthreads();
        f32x4 fwv[2][2];
#pragma unroll
        for (int bj = 0; bj < 2; ++bj)
#pragma unroll
            for (int n = 0; n < 2; ++n) fwv[bj][n] = *(const f32x4*)(fw + col0 + bj * 128 + n * 16);
#pragma unroll
        for (int ai = 0; ai < 2; ++ai)
#pragma unroll
            for (int m = 0; m < 4; ++m) { const int row = ai * 128 + wr * 64 + m * 16 + fr; const size_t off = (size_t)(u.pm * 256 + row) * DM + col0; const float rs = R[row];
#pragma unroll
                for (int bj = 0; bj < 2; ++bj)
#pragma unroll
                    for (int n = 0; n < 2; ++n) *(f32x4*)(y + off + bj * 128 + n * 16) = acc[ai][bj][m][n] * rs * fwv[bj][n]; }
    }
};
__device__ __forceinline__ void final_norm_row(float* rowp, const float* fw, int lane) {
    GAS f32x4* xr = (GAS f32x4*)rowp + lane; const GAS f32x4* wr = (const GAS f32x4*)fw + lane;
    f32x4 v[8], wv[8]; float s = 0.f;
#pragma unroll
    for (int i = 0; i < 8; ++i) { v[i] = xr[64 * i]; wv[i] = wr[64 * i]; }
#pragma unroll
    for (int i = 0; i < 8; ++i) s += (v[i].x * v[i].x + v[i].y * v[i].y) + (v[i].z * v[i].z + v[i].w * v[i].w);
    const float rstd = 1.f / sqrtf(wave_sum(s) * (1.f / DM) + RMS_EPS);
#pragma unroll
    for (int i = 0; i < 8; ++i) { const f32x4 ww = wv[i]; xr[64 * i] = (f32x4){v[i].x * rstd * ww.x, v[i].y * rstd * ww.y, v[i].z * rstd * ww.z, v[i].w * rstd * ww.w}; }
}
__device__ __forceinline__ void p5_phase(Frame& F) {
    pg8::Gemm g{F.MIX, F.WOUTT, MP, DM, DM}; pg8::StaticOrder S; S.init(MP, DM, F.G, (int)blockIdx.x);
    if (F.G == 256) {
        EpiOutF E{F.x_prompt, F.out + O_Y, F.final_norm_w, F.XCH, F.ctl + CW_PCNT};
        pg8::gemm_phase<EpiOutF, pg8::StaticOrder, false, true>(F.lds, g, S, E);
        __syncthreads();
    } else {
        EpiOut E{F.x_prompt, F.out + O_Y};
        pg8::gemm_phase<EpiOut, pg8::StaticOrder, true, true>(F.lds, g, S, E);
    }
    for (int j = blockIdx.x; j < 64; j += F.G) {
        p5_sample_out(F, j);
        if (F.G == 256) {
            LAS unsigned* flag = (LAS unsigned*)(F.lds + 40960);
            VM_WAIT(); __syncthreads();
            if (F.tid == 0) {
                __builtin_amdgcn_fence(__ATOMIC_RELEASE, "agent"); VM_WAIT();
                const unsigned old = __hip_atomic_fetch_add(F.ctl + CW_SCNT, 1u, __ATOMIC_RELAXED, __HIP_MEMORY_SCOPE_AGENT);
                if (old == 63u) { __builtin_amdgcn_fence(__ATOMIC_ACQUIRE, "agent"); VM_WAIT(); }
                *flag = (old == 63u) ? 1u : 0u;
            }
            __syncthreads();
            if (*flag) {
                static_assert(MS == 4 * NWAVES, "4 sample rows per wave");
                const GAS f32x4* wr = (const GAS f32x4*)F.final_norm_w + F.lane;
                f32x4 v[4][8], wv[8];
#pragma unroll
                for (int q = 0; q < 4; ++q) { const GAS f32x4* xr = (const GAS f32x4*)(F.out + O_YS + (size_t)(F.wave + NWAVES * q) * DM) + F.lane;
#pragma unroll
                    for (int i = 0; i < 8; ++i) v[q][i] = xr[64 * i]; }
#pragma unroll
                for (int i = 0; i < 8; ++i) wv[i] = wr[64 * i];
#pragma unroll
                for (int q = 0; q < 4; ++q) { float ss = 0.f;
#pragma unroll
                    for (int i = 0; i < 8; ++i) ss += (v[q][i].x * v[q][i].x + v[q][i].y * v[q][i].y) + (v[q][i].z * v[q][i].z + v[q][i].w * v[q][i].w);
                    const float rstd = 1.f / sqrtf(wave_sum(ss) * (1.f / DM) + RMS_EPS);
                    GAS f32x4* xo = (GAS f32x4*)(F.out + O_YS + (size_t)(F.wave + NWAVES * q) * DM) + F.lane;
#pragma unroll
                    for (int i = 0; i < 8; ++i) xo[64 * i] = (f32x4){v[q][i].x * rstd * wv[i].x, v[q][i].y * rstd * wv[i].y, v[q][i].z * rstd * wv[i].z, v[q][i].w * rstd * wv[i].w}; }
            }
            __syncthreads();
        }
    }
}
__device__ __forceinline__ void p6_phase(Frame& F) {
    const int gw = blockIdx.x * NWAVES + F.wave, NGW = F.G * NWAVES;
    for (int m = gw; m < MROWS; m += NGW) final_norm_row((m < MP) ? F.out + O_Y + (size_t)m * DM : F.out + O_YS + (size_t)(m - MP) * DM, F.final_norm_w, F.lane);
}
__device__ __forceinline__ void p1_phase(Frame& F) {
    pg8::Gemm g{F.XN, F.WINT, MPAD, NPAD, DM}; pg8::StaticOrder S; S.init(MPAD, NPAD, F.G, (int)blockIdx.x);
    EpiIn E{F.P, F.out, F.WI, F.IG, F.LF, F.KIB, F.b_i, F.b_f, F.KVC};
    pg8::gemm_phase<EpiIn, pg8::StaticOrder, true, true>(F.lds, g, S, E);
}
#ifndef MK_N_LAUNCHES
#define MK_N_LAUNCHES 1
#endif
constexpr int N_PHASES = 7;
struct Args { const void* in[16]; float* out; unsigned char* ws; int ph_lo, ph_hi, two, pad; };
__global__ void __launch_bounds__(NTHR, 2) mk_fwd(Args args) {
    extern __shared__ __attribute__((aligned(16))) unsigned char lds[];
    Frame F;
    F.lds = (LAS unsigned char*)lds;
    F.tid = threadIdx.x; F.lane = F.tid & 63; F.wave = __builtin_amdgcn_readfirstlane(F.tid >> 6);
    F.G = gridDim.x; { const int bx = blockIdx.x; F.vcu = (F.G % 8 == 0) ? (bx % 8) * (F.G / 8) + bx / 8 : bx; }
    unsigned char* ws = args.ws;
    F.x_prompt = (const float*)args.in[0]; F.x_sample = (const float*)args.in[1]; F.cache_k = (const float*)args.in[2]; F.cache_v = (const float*)args.in[3];
    F.cache_ik = (const float*)args.in[4]; F.state_C = (const float*)args.in[5]; F.state_n = (const float*)args.in[6]; F.state_m = (const float*)args.in[7];
    F.page_table = (const int*)args.in[8]; F.norm_w = (const float*)args.in[9]; F.w_in = (const float*)args.in[10]; F.b_i = (const float*)args.in[11];
    F.b_f = (const float*)args.in[12]; F.ml_norm_w = (const float*)args.in[13]; F.w_out = (const float*)args.in[14]; F.final_norm_w = (const float*)args.in[15];
    F.out = args.out; F.two = args.two;
    F.WINT = (bf16*)(ws + WS_WINT); F.WOUTT = (bf16*)(ws + WS_WOUTT); F.XN = (bf16*)(ws + WS_XN); F.P = (bf16*)(ws + WS_P); F.KIB = (bf16*)(ws + WS_KIB);
    F.MIX = (bf16*)(ws + WS_MIX); F.CST = (bf16*)(ws + WS_CST);
    F.WI = (float*)(ws + WS_WI); F.IG = (float*)(ws + WS_IG); F.LF = (float*)(ws + WS_LF); F.UN = (float*)(ws + WS_UN); F.CHG = (float*)(ws + WS_CHG);
    F.NST = (float*)(ws + WS_NST); F.MST = (float*)(ws + WS_MST); F.SS = (float*)(ws + WS_SS); F.SC = (float*)(ws + WS_SC2); F.UP = (float*)(ws + WS_UP);
    F.BMT = (unsigned*)(ws + WS_BMT2); F.SIDX = (int*)(ws + WS_SIDX); F.XCH = (float*)(ws + WS_XCH); F.KVC = (bf16*)(ws + WS_KVC); F.ctl = (unsigned*)(ws + WS_CTL);
    volatile LAS unsigned* MISC = (volatile LAS unsigned*)(F.lds + MISC_OFF);
    for (int u = F.tid; u < (LDS_BYTES - MISC_OFF) / 4; u += NTHR) MISC[u] = 0u;
    __syncthreads();
    const int lo = args.ph_lo, hi = args.ph_hi;
    XcdBarrier bar; bar.bar = (unsigned*)(ws + WS_CTL) + CW_BAR; bar.x = 0; bar.st = nullptr;
    if (hi - lo > 1) bar = xcd_barrier_post((unsigned*)(ws + WS_CTL) + CW_BAR, MISC + 8);
#ifndef ONLY_PH
#define ONLY_PH -1
#endif
    F.bar = &bar;
#define IN(k) ((ONLY_PH < 0 || ONLY_PH == (k)) && lo <= (k) && (k) < hi)
#define SEAM(k) do { if (IN(k) && IN((k) + 1)) xcd_barrier(bar); } while (0)

#ifndef DUP_PH
#define DUP_PH -1
#endif
#define RUN_PHASE(k, call) do { if (IN(k)) { call; if (DUP_PH == (k)) { xcd_barrier(bar); call; } } } while (0)
    RUN_PHASE(0, p0_prologue(F));
    SEAM(0);
    RUN_PHASE(1, p1_phase(F));
    SEAM(1);
    RUN_PHASE(2, p2_phase(F));
    SEAM(2);
    RUN_PHASE(3, p3_phase(F));
    SEAM(3);
#ifndef XBAR_N
#define XBAR_N 0
#endif
    for (int xb_ = 0; xb_ < XBAR_N * (F.two / 2); ++xb_) xcd_barrier(bar);
    RUN_PHASE(4, p4_phase(F));
    SEAM(4);
    RUN_PHASE(5, p5_phase(F));
    if (F.G != 256) { SEAM(5); RUN_PHASE(6, p6_phase(F)); }
}

extern "C" void kernel_launch(void* const* d_in, const int* in_sizes, int n_in, void* d_out, int out_size, void* d_ws, size_t ws_size, hipStream_t stream) {
    static int grid = 0;
    if (grid == 0) {
        if (n_in != 16 || (size_t)out_size != O_END || ws_size < WS_END) { fprintf(stderr, "kernel_launch: unexpected shapes (n_in %d out %d ws %zu)\n", n_in, out_size, ws_size); grid = -1; return; }
        int dev = 0, cus = 0, per_cu = 0;
        if (hipGetDevice(&dev) != hipSuccess || hipDeviceGetAttribute(&cus, hipDeviceAttributeMultiprocessorCount, dev) != hipSuccess) { grid = -1; return; }
        if (hipFuncSetAttribute((const void*)mk_fwd, hipFuncAttributeMaxDynamicSharedMemorySize, LDS_BYTES) != hipSuccess) { fprintf(stderr, "kernel_launch: hipFuncSetAttribute failed\n"); grid = -1; return; }
        if (hipOccupancyMaxActiveBlocksPerMultiprocessor(&per_cu, (const void*)mk_fwd, NTHR, LDS_BYTES) != hipSuccess || per_cu < 1) { fprintf(stderr, "kernel_launch: occupancy query says %d\n", per_cu); }
        (void)hipGetLastError();
        grid = cus;
    }
    if (grid < 0) return;
    if (hipMemsetAsync((char*)d_ws + WS_CTL, 0, CTL_ZERO_BYTES, stream) != hipSuccess) return;
    Args a{};
    for (int i = 0; i < 16; ++i) a.in[i] = d_in[i];
    a.out = (float*)d_out; a.ws = (unsigned char*)d_ws; a.two = 2; a.pad = 0;
    if (MK_N_LAUNCHES == 1) { a.ph_lo = 0; a.ph_hi = N_PHASES; hipLaunchKernelGGL(mk_fwd, dim3(grid), dim3(NTHR), LDS_BYTES, stream, a); }
    else for (int p = 0; p < N_PHASES; ++p) { a.ph_lo = p; a.ph_hi = p + 1; hipLaunchKernelGGL(mk_fwd, dim3(grid), dim3(NTHR), LDS_BYTES, stream, a); }
}
```
